# Optimizing an MI355X kernel written in HIP

```python
import math
import jax, jax.numpy as jnp
from jax import lax
import numpy as np

D_MODEL = 1024
BATCH = 2
SEQ = 16384
DEPTH = 2

HEAD_DIM = 64
BLOCK = 128
EPS = 1e-6
NEG_INF = -1e30
SWA_HEADS = 8
SWA_KV_HEADS = 2
SWA_WINDOW = 128
MLA_HEADS = 8
MLA_Q_RANK = 256
MLA_KV_RANK = 128
MLA_NOPE_DIM = 64
MLA_ROPE_DIM = 32
MLA_V_DIM = 64
MLA_QK_DIM = MLA_NOPE_DIM + MLA_ROPE_DIM
ROPE_THETA = 10000.0
DIFF_HEADS = 8
DIFF_DIM = 64
MEM_TOKENS = 256
MEM_HEADS = 4
MEM_HEAD_DIM = 128
D_FF = -(-8 * D_MODEL // (3 * 256)) * 256

SWA_Q_W = SWA_HEADS * HEAD_DIM
SWA_KV_W = SWA_KV_HEADS * HEAD_DIM
EVEN_SPLITS = (SWA_Q_W, SWA_Q_W + SWA_KV_W, SWA_Q_W + 2 * SWA_KV_W,
               SWA_Q_W + 2 * SWA_KV_W + MLA_Q_RANK,
               SWA_Q_W + 2 * SWA_KV_W + MLA_Q_RANK + MLA_KV_RANK)
IN_EVEN = SWA_Q_W + 2 * SWA_KV_W + MLA_Q_RANK + MLA_KV_RANK + MLA_ROPE_DIM
MIX_EVEN = SWA_HEADS * HEAD_DIM + MLA_HEADS * MLA_V_DIM
DIFF_W = DIFF_HEADS * 2 * DIFF_DIM
N_EVEN = (DEPTH + 1) // 2
N_ODD = DEPTH // 2

kernel_name = "hybrid_swa_mla_diffattn_mem_swiglu"


def rms_norm(x, g):
    xf = x.astype(jnp.float32)
    y = xf * lax.rsqrt(jnp.mean(xf * xf, axis=-1, keepdims=True) + EPS)
    return (y * g.astype(jnp.float32)).astype(x.dtype)


def alibi_slopes(n):
    return jnp.asarray([2.0 ** (-8.0 * (i + 1) / n) for i in range(n)], jnp.float32)


def rope(x, positions):
    half = x.shape[-1] // 2
    inv = ROPE_THETA ** (-jnp.arange(half, dtype=jnp.float32) / half)
    ang = positions.astype(jnp.float32)[:, :, None, None] * inv
    cos, sin = jnp.cos(ang), jnp.sin(ang)
    xf = x.astype(jnp.float32)
    x1, x2 = xf[..., :half], xf[..., half:]
    return jnp.concatenate([x1 * cos - x2 * sin, x2 * cos + x1 * sin], axis=-1).astype(x.dtype)


def _query_blocks(q):
    B, S = q.shape[:2]
    return q.reshape(B, S // BLOCK, BLOCK, *q.shape[2:]).swapaxes(0, 1)


def _merge_blocks(o):
    nb, B = o.shape[:2]
    return o.swapaxes(0, 1).reshape(B, nb * BLOCK, *o.shape[3:])


def _causal_probs(qblk, k, n, slopes):
    S = k.shape[1]
    s = jnp.einsum('bqhd,bkhd->bhqk', qblk, k, preferred_element_type=jnp.float32) * (qblk.shape[-1] ** -0.5)
    dist = (n * BLOCK + jnp.arange(BLOCK))[:, None] - jnp.arange(S)[None, :]
    if slopes is not None:
        s = s - slopes[None, :, None, None] * dist.astype(jnp.float32)
    s = jnp.where(dist >= 0, s, NEG_INF)
    return jax.nn.softmax(s, axis=-1)


def swa_sink_attention(q, k, v, sinks, slopes):
    B, S, H, D = q.shape
    Hk = k.shape[2]
    G = H // Hk
    nb = S // BLOCK
    qb = q.reshape(B, nb, BLOCK, Hk, G, D)
    pad = jnp.zeros((B, BLOCK, Hk, D), k.dtype)
    kp = jnp.concatenate([pad, k], axis=1).reshape(B, nb + 1, BLOCK, Hk, D)
    vp = jnp.concatenate([pad.astype(v.dtype), v], axis=1).reshape(B, nb + 1, BLOCK, Hk, D)
    kb = jnp.concatenate([kp[:, :-1], kp[:, 1:]], axis=2)
    vb = jnp.concatenate([vp[:, :-1], vp[:, 1:]], axis=2)
    s = jnp.einsum('bnqhgd,bnkhd->bnhgqk', qb, kb, preferred_element_type=jnp.float32) * (D ** -0.5)
    dist = jnp.arange(BLOCK)[:, None] - jnp.arange(2 * BLOCK)[None, :] + BLOCK
    src = jnp.arange(nb)[:, None, None] * BLOCK - BLOCK + jnp.arange(2 * BLOCK)[None, None, :]
    valid = ((dist >= 0) & (dist < SWA_WINDOW))[None] & (src >= 0)
    s = s - slopes.reshape(Hk, G)[:, :, None, None] * dist.astype(jnp.float32)
    s = jnp.where(valid[None, :, None, None], s, NEG_INF)
    sink = jnp.broadcast_to(sinks.astype(jnp.float32).reshape(Hk, G)[None, None, :, :, None, None],
                            s.shape[:-1] + (1,))
    p = jax.nn.softmax(jnp.concatenate([s, sink], axis=-1), axis=-1)[..., :-1]
    o = jnp.einsum('bnhgqk,bnkhd->bnqhgd', p.astype(v.dtype), vb)
    return o.reshape(B, S, H * D)


def mla_attention(q, k, v):
    def body(args):
        qblk, n = args
        p = _causal_probs(qblk, k, n, None)
        return jnp.einsum('bhqk,bkhd->bqhd', p.astype(v.dtype), v)
    o = _merge_blocks(lax.map(body, (_query_blocks(q), jnp.arange(q.shape[1] // BLOCK))))
    return o.reshape(q.shape[0], q.shape[1], -1)


def diff_attention(q1, q2, k1, k2, v, lam, slopes):
    def body(args):
        q1b, q2b, n = args
        a = _causal_probs(q1b, k1, n, slopes) - lam * _causal_probs(q2b, k2, n, slopes)
        return jnp.einsum('bhqk,bkhd->bqhd', a.astype(v.dtype), v)
    return _merge_blocks(lax.map(body, (_query_blocks(q1), _query_blocks(q2), jnp.arange(q1.shape[1] // BLOCK))))


def even_mixer(h, positions, w_in, swa_q_gain, swa_k_gain, sinks, q_latent_norm, kv_latent_norm,
               w_uq, w_ukv, mla_q_gain, mla_k_gain, w_out):
    B, S, _ = h.shape
    z = h @ w_in
    qa, ka, va, cq, ckv, kr = jnp.split(z, EVEN_SPLITS, axis=-1)
    qa = rms_norm(qa.reshape(B, S, SWA_HEADS, HEAD_DIM), swa_q_gain)
    ka = rms_norm(ka.reshape(B, S, SWA_KV_HEADS, HEAD_DIM), swa_k_gain)
    va = va.reshape(B, S, SWA_KV_HEADS, HEAD_DIM)
    out_a = swa_sink_attention(qa, ka, va, sinks, alibi_slopes(SWA_HEADS))
    q_full = (rms_norm(cq, q_latent_norm) @ w_uq).reshape(B, S, MLA_HEADS, MLA_QK_DIM)
    kv = (rms_norm(ckv, kv_latent_norm) @ w_ukv).reshape(B, S, MLA_HEADS, MLA_NOPE_DIM + MLA_V_DIM)
    k_full = jnp.concatenate([kv[..., :MLA_NOPE_DIM],
                              jnp.broadcast_to(kr[:, :, None, :], (B, S, MLA_HEADS, MLA_ROPE_DIM))], axis=-1)
    vb = kv[..., MLA_NOPE_DIM:]
    q_full = rms_norm(q_full, mla_q_gain)
    k_full = rms_norm(k_full, mla_k_gain)
    qb = jnp.concatenate([q_full[..., :MLA_NOPE_DIM], rope(q_full[..., MLA_NOPE_DIM:], positions)], axis=-1)
    kb = jnp.concatenate([k_full[..., :MLA_NOPE_DIM], rope(k_full[..., MLA_NOPE_DIM:], positions)], axis=-1)
    out_b = mla_attention(qb, kb, vb)
    return jnp.concatenate([out_a, out_b], axis=-1) @ w_out


def odd_mixer(h, w_qkv, q_gain, k_gain, lambdas, subln, w_out, lambda_init):
    B, S, _ = h.shape
    q, k, v = jnp.split(h @ w_qkv, 3, axis=-1)
    q = rms_norm(q.reshape(B, S, DIFF_HEADS, 2, DIFF_DIM), q_gain)
    k = rms_norm(k.reshape(B, S, DIFF_HEADS, 2, DIFF_DIM), k_gain)
    v = v.reshape(B, S, DIFF_HEADS, 2 * DIFF_DIM)
    lf = lambdas.astype(jnp.float32)
    lam = jnp.exp(jnp.sum(lf[0] * lf[1])) - jnp.exp(jnp.sum(lf[2] * lf[3])) + lambda_init
    o = diff_attention(q[:, :, :, 0], q[:, :, :, 1], k[:, :, :, 0], k[:, :, :, 1], v, lam,
                       alibi_slopes(DIFF_HEADS))
    o = rms_norm(o, subln) * (1.0 - lambda_init)
    return o.reshape(B, S, DIFF_W) @ w_out


def mem_attention(h, m, w_q, w_kv, q_gain, k_gain, w_out):
    B, S, _ = h.shape
    q = rms_norm((h @ w_q).reshape(B, S, MEM_HEADS, MEM_HEAD_DIM), q_gain)
    k, v = jnp.split(m @ w_kv, 2, axis=-1)
    k = rms_norm(k.reshape(B, MEM_TOKENS, MEM_HEADS, MEM_HEAD_DIM), k_gain)
    v = v.reshape(B, MEM_TOKENS, MEM_HEADS, MEM_HEAD_DIM)
    s = jnp.einsum('bshd,bmhd->bhsm', q, k, preferred_element_type=jnp.float32) * (MEM_HEAD_DIM ** -0.5)
    p = jax.nn.softmax(s, axis=-1)
    o = jnp.einsum('bhsm,bmhd->bshd', p.astype(v.dtype), v)
    return o.reshape(B, S, MEM_HEADS * MEM_HEAD_DIM) @ w_out


def swiglu(h, w_gate, w_up, w_down):
    return (jax.nn.silu(h @ w_gate) * (h @ w_up)) @ w_down


def setup_inputs(seed: int = 0) -> dict:
    key = jax.random.key(seed)
    ks = iter(jax.random.split(key, 48))

    def w(shape, fan_in):
        return jax.random.normal(next(ks), shape, jnp.float32) * (fan_in ** -0.5)

    def gain(shape):
        return 1.0 + 0.02 * jax.random.normal(next(ks), shape, jnp.float32)

    x = jax.random.normal(next(ks), (BATCH, SEQ, D_MODEL), jnp.float32)
    mem = jax.random.normal(next(ks), (BATCH, MEM_TOKENS, D_MODEL), jnp.float32)
    offset = jax.random.randint(next(ks), (BATCH, 1), 0, 1024, dtype=jnp.int32)
    positions = (offset + jnp.arange(SEQ, dtype=jnp.int32)[None, :]).astype(jnp.int32)
    return {
        "x": x,
        "mem": mem,
        "positions": positions,
        "mix_norm": gain((DEPTH, D_MODEL)),
        "ev_w_in": w((N_EVEN, D_MODEL, IN_EVEN), D_MODEL),
        "ev_swa_q_gain": gain((N_EVEN, HEAD_DIM)),
        "ev_swa_k_gain": gain((N_EVEN, HEAD_DIM)),
        "ev_sinks": 0.5 * jax.random.normal(next(ks), (N_EVEN, SWA_HEADS), jnp.float32),
        "ev_q_latent_norm": gain((N_EVEN, MLA_Q_RANK)),
        "ev_kv_latent_norm": gain((N_EVEN, MLA_KV_RANK)),
        "ev_w_uq": w((N_EVEN, MLA_Q_RANK, MLA_HEADS * MLA_QK_DIM), MLA_Q_RANK),
        "ev_w_ukv": w((N_EVEN, MLA_KV_RANK, MLA_HEADS * (MLA_NOPE_DIM + MLA_V_DIM)), MLA_KV_RANK),
        "ev_mla_q_gain": gain((N_EVEN, MLA_QK_DIM)),
        "ev_mla_k_gain": gain((N_EVEN, MLA_QK_DIM)),
        "ev_w_out": w((N_EVEN, MIX_EVEN, D_MODEL), MIX_EVEN),
        "od_w_qkv": w((N_ODD, D_MODEL, 3 * DIFF_W), D_MODEL),
        "od_q_gain": gain((N_ODD, DIFF_DIM)),
        "od_k_gain": gain((N_ODD, DIFF_DIM)),
        "od_lambda": 0.1 * jax.random.normal(next(ks), (N_ODD, 4, DIFF_DIM), jnp.float32),
        "od_subln": gain((N_ODD, 2 * DIFF_DIM)),
        "od_w_out": w((N_ODD, DIFF_W, D_MODEL), DIFF_W),
        "mem_q_norm": gain((DEPTH, D_MODEL)),
        "mem_kv_norm": gain((DEPTH, D_MODEL)),
        "mem_w_q": w((DEPTH, D_MODEL, MEM_HEADS * MEM_HEAD_DIM), D_MODEL),
        "mem_w_kv": w((DEPTH, D_MODEL, 2 * MEM_HEADS * MEM_HEAD_DIM), D_MODEL),
        "mem_q_gain": gain((DEPTH, MEM_HEAD_DIM)),
        "mem_k_gain": gain((DEPTH, MEM_HEAD_DIM)),
        "mem_w_out": w((DEPTH, MEM_HEADS * MEM_HEAD_DIM, D_MODEL), MEM_HEADS * MEM_HEAD_DIM),
        "ffn_norm": gain((DEPTH, D_MODEL)),
        "ffn_w_gate": w((DEPTH, D_MODEL, D_FF), D_MODEL),
        "ffn_w_up": w((DEPTH, D_MODEL, D_FF), D_MODEL),
        "ffn_w_down": w((DEPTH, D_FF, D_MODEL), D_FF),
    }


def reference(x, mem, positions, mix_norm, ev_w_in, ev_swa_q_gain, ev_swa_k_gain, ev_sinks,
              ev_q_latent_norm, ev_kv_latent_norm, ev_w_uq, ev_w_ukv, ev_mla_q_gain, ev_mla_k_gain,
              ev_w_out, od_w_qkv, od_q_gain, od_k_gain, od_lambda, od_subln, od_w_out,
              mem_q_norm, mem_kv_norm, mem_w_q, mem_w_kv, mem_q_gain, mem_k_gain, mem_w_out,
              ffn_norm, ffn_w_gate, ffn_w_up, ffn_w_down):
    for l in range(DEPTH):
        h = rms_norm(x, mix_norm[l])
        if l % 2 == 0:
            e = l // 2
            y = even_mixer(h, positions, ev_w_in[e], ev_swa_q_gain[e], ev_swa_k_gain[e], ev_sinks[e],
                           ev_q_latent_norm[e], ev_kv_latent_norm[e], ev_w_uq[e], ev_w_ukv[e],
                           ev_mla_q_gain[e], ev_mla_k_gain[e], ev_w_out[e])
        else:
            o = l // 2
            lambda_init = 0.8 - 0.6 * math.exp(-0.3 * l)
            y = odd_mixer(h, od_w_qkv[o], od_q_gain[o], od_k_gain[o], od_lambda[o], od_subln[o],
                          od_w_out[o], lambda_init)
        x = x + y
        x = x + mem_attention(rms_norm(x, mem_q_norm[l]), rms_norm(mem, mem_kv_norm[l]), mem_w_q[l],
                              mem_w_kv[l], mem_q_gain[l], mem_k_gain[l], mem_w_out[l])
        x = x + swiglu(rms_norm(x, ffn_norm[l]), ffn_w_gate[l], ffn_w_up[l], ffn_w_down[l])
    return x
```

```cpp
#include <hip/hip_runtime.h>
#include <hip/hip_cooperative_groups.h>
#include <cstdio>
#include <cstdint>
namespace cg = cooperative_groups;
#ifndef MK_MULTI
#define MK_MULTI 0
#endif
namespace pg8 {
#define PG8_LAS __attribute__((address_space(3)))
typedef unsigned short bf16_t;
typedef short bf16x8 __attribute__((ext_vector_type(8)));
typedef float f32x4 __attribute__((ext_vector_type(4)));
typedef unsigned u32x4 __attribute__((ext_vector_type(4)));
constexpr int BM = 256, BK = 64, HALF = 128, HTB = HALF * BK * 2  , STAGE_BYTES = 8 * HTB, NXCD = 8, WGM = 8;

__host__ __device__ __forceinline__ int lds_byte(int r, int c) { const int st = (r >> 4) * 2 + (c >> 5), rr = r & 15, cc = c & 31, ob = rr * 64 + cc * 2; return st * 1024 + (ob ^ (((ob >> 9) & 1) << 5)); }
__host__ __device__ __forceinline__ void stage_rc(int b, int& R, int& C) { const int st = b / 1024, sb = b % 1024, swz = sb ^ (((sb >> 9) & 1) << 5); R = (st >> 1) * 16 + swz / 64; C = (st & 1) * 32 + (swz % 64) / 2; }
__host__ __device__ __forceinline__ int perm32(int rho) { const int n = rho >> 4, i = rho & 15; return 8 * (i >> 2) + 4 * n + (i & 3); }

struct Unit { int pm, pn; };
struct Gemm { const bf16_t* A; const bf16_t* Bt; int M, N, K; };

struct StaticOrder {
    int nM, nN, nwg, G, c;
    __host__ __device__ void init(int M, int N, int G_, int c_) { nM = M / BM; nN = N / BM; nwg = nM * nN; G = G_; c = c_; }
    __host__ __device__ bool next(int i, Unit& u) const {
        const long L = (long)i * G + c; if (L >= nwg) return false;
        int wgid = (int)L; { const int q = nwg / NXCD, r = nwg % NXCD, xcd = wgid % NXCD, off = wgid / NXCD; wgid = (xcd < r ? xcd * (q + 1) : r * (q + 1) + (xcd - r) * q) + off; }
        const int nig = WGM * nN, gid = wgid / nig, fm = gid * WGM, gsz = (nM - fm) < WGM ? (nM - fm) : WGM;
        u.pm = fm + ((wgid % nig) % gsz); u.pn = (wgid % nig) / gsz; return true;
    }
    __device__ __forceinline__ void a_ready(const Unit&) const {}
    __device__ __forceinline__ void done(const Unit&) const {}
};

__device__ __forceinline__ unsigned cvt_pk_bf16(float lo, float hi) { unsigned r; asm volatile("v_cvt_pk_bf16_f32 %0, %1, %2" : "=v"(r) : "v"(lo), "v"(hi)); return r; }
struct EpiStore {
    static constexpr bool PERM = true, AFTER_DRAIN = false;
    bf16_t* O; int ldc;
    __device__ __forceinline__ void operator()(const f32x4 (&acc)[2][2][4][2], const Unit& u, int wr, int wc, int fr, int fq) const {
        const int row0 = u.pm * BM + wr * 64 + fr, col0 = u.pn * BM + wc * 32 + 8 * fq;
#pragma unroll
        for (int ai = 0; ai < 2; ++ai)
#pragma unroll
            for (int m = 0; m < 4; ++m) { bf16_t* rowp = O + (size_t)(row0 + ai * HALF + m * 16) * ldc + col0;
#pragma unroll
                for (int bj = 0; bj < 2; ++bj) { const f32x4 v0 = acc[ai][bj][m][0], v1 = acc[ai][bj][m][1];
                    u32x4 w; w.x = cvt_pk_bf16(v0[0], v0[1]); w.y = cvt_pk_bf16(v0[2], v0[3]); w.z = cvt_pk_bf16(v1[0], v1[1]); w.w = cvt_pk_bf16(v1[2], v1[3]);
                    *(u32x4*)(rowp + bj * HALF) = w; } }
    }
};
struct EpiResid {
    static constexpr bool PERM = true, AFTER_DRAIN = false;
    const float* R; float* O; int ld;
    __device__ __forceinline__ void operator()(const f32x4 (&acc)[2][2][4][2], const Unit& u, int wr, int wc, int fr, int fq) const {
        const int row0 = u.pm * BM + wr * 64 + fr, col0 = u.pn * BM + wc * 32 + 8 * fq;
#pragma unroll
        for (int ai = 0; ai < 2; ++ai)
#pragma unroll
            for (int m = 0; m < 4; ++m) { const size_t off = (size_t)(row0 + ai * HALF + m * 16) * ld + col0; __builtin_amdgcn_sched_barrier(0);
#pragma unroll
                for (int bj = 0; bj < 2; ++bj) {
                    const f32x4 r0 = *(const f32x4*)(R + off + bj * HALF), r1 = *(const f32x4*)(R + off + bj * HALF + 4);
                    *(f32x4*)(O + off + bj * HALF) = r0 + acc[ai][bj][m][0]; *(f32x4*)(O + off + bj * HALF + 4) = r1 + acc[ai][bj][m][1]; } }
    }
};
template <bool RF32, bool OF32> struct EpiResX {
    static constexpr bool PERM = true, AFTER_DRAIN = false;
    const void* R; void* O; int ld;
    __device__ __forceinline__ void operator()(const f32x4 (&acc)[2][2][4][2], const Unit& u, int wr, int wc, int fr, int fq) const {
        const int row0 = u.pm * BM + wr * 64 + fr, col0 = u.pn * BM + wc * 32 + 8 * fq;
#pragma unroll
        for (int ai = 0; ai < 2; ++ai)
#pragma unroll
            for (int m = 0; m < 4; ++m) { const size_t off = (size_t)(row0 + ai * HALF + m * 16) * ld + col0; __builtin_amdgcn_sched_barrier(0);
#pragma unroll
                for (int bj = 0; bj < 2; ++bj) {
                    f32x4 r0, r1;
                    if (RF32) { r0 = *(const f32x4*)((const float*)R + off + bj * HALF); r1 = *(const f32x4*)((const float*)R + off + bj * HALF + 4); }
                    else { const u32x4 w = *(const u32x4*)((const bf16_t*)R + off + bj * HALF);
                        r0 = (f32x4){__builtin_bit_cast(float, w.x << 16), __builtin_bit_cast(float, w.x & 0xffff0000u), __builtin_bit_cast(float, w.y << 16), __builtin_bit_cast(float, w.y & 0xffff0000u)};
                        r1 = (f32x4){__builtin_bit_cast(float, w.z << 16), __builtin_bit_cast(float, w.z & 0xffff0000u), __builtin_bit_cast(float, w.w << 16), __builtin_bit_cast(float, w.w & 0xffff0000u)}; }
                    const f32x4 n0 = r0 + acc[ai][bj][m][0], n1 = r1 + acc[ai][bj][m][1];
                    if (OF32) { *(f32x4*)((float*)O + off + bj * HALF) = n0; *(f32x4*)((float*)O + off + bj * HALF + 4) = n1; }
                    else { u32x4 w; w.x = cvt_pk_bf16(n0[0], n0[1]); w.y = cvt_pk_bf16(n0[2], n0[3]); w.z = cvt_pk_bf16(n1[0], n1[1]); w.w = cvt_pk_bf16(n1[2], n1[3]);
                        *(u32x4*)((bf16_t*)O + off + bj * HALF) = w; } } }
    }
};
struct EpiQKV {
    static constexpr bool PERM = true, AFTER_DRAIN = false;
    bf16_t* QD; bf16_t* KD; bf16_t* V; const float* gq; const float* gk; float qscale;
    __device__ __forceinline__ void operator()(const f32x4 (&acc)[2][2][4][2], const Unit& u, int wr, int wc, int fr, int fq) const {
        const int row0 = u.pm * BM + wr * 64 + fr;
        if (u.pn >= 8) {
            const int col0 = u.pn * BM + wc * 32 + 8 * fq;
#pragma unroll
            for (int ai = 0; ai < 2; ++ai)
#pragma unroll
                for (int m = 0; m < 4; ++m) { bf16_t* rowp = V + (size_t)(row0 + ai * HALF + m * 16) * 3072 + col0;
#pragma unroll
                    for (int bj = 0; bj < 2; ++bj) { const f32x4 v0 = acc[ai][bj][m][0], v1 = acc[ai][bj][m][1];
                        u32x4 w; w.x = cvt_pk_bf16(v0[0], v0[1]); w.y = cvt_pk_bf16(v0[2], v0[3]); w.z = cvt_pk_bf16(v1[0], v1[1]); w.w = cvt_pk_bf16(v1[2], v1[3]);
                        *(u32x4*)(rowp + bj * HALF) = w; } }
        } else {
            const bool isk = u.pn >= 4; bf16_t* D = isk ? KD : QD; const float* g = (isk ? gk : gq) + 8 * fq; const float sc = isk ? 1.0f : qscale;
            const int lc0 = (u.pn & 3) * 256 + 64 * wc + 8 * fq;
            const f32x4 ga0 = *(const f32x4*)g, ga1 = *(const f32x4*)(g + 4), gb0 = *(const f32x4*)(g + 32), gb1 = *(const f32x4*)(g + 36);
#pragma unroll
            for (int ai = 0; ai < 2; ++ai)
#pragma unroll
                for (int m = 0; m < 4; ++m) { __builtin_amdgcn_sched_barrier(0);
                    const f32x4 a0 = acc[ai][0][m][0], a1 = acc[ai][0][m][1], b0 = acc[ai][1][m][0], b1 = acc[ai][1][m][1];
                    float ss = ((a0[0] * a0[0] + a0[1] * a0[1]) + (a0[2] * a0[2] + a0[3] * a0[3])) + ((a1[0] * a1[0] + a1[1] * a1[1]) + (a1[2] * a1[2] + a1[3] * a1[3]))
                             + ((b0[0] * b0[0] + b0[1] * b0[1]) + (b0[2] * b0[2] + b0[3] * b0[3])) + ((b1[0] * b1[0] + b1[1] * b1[1]) + (b1[2] * b1[2] + b1[3] * b1[3]));
                    ss += __shfl_xor(ss, 16); ss += __shfl_xor(ss, 32);
                    const float r = sc / __builtin_sqrtf(ss * (1.0f / 64.0f) + 1e-6f);
                    const f32x4 x0 = a0 * ga0 * r, x1 = a1 * ga1 * r, y0 = b0 * gb0 * r, y1 = b1 * gb1 * r;
                    bf16_t* rowp = D + (size_t)(row0 + ai * HALF + m * 16) * 1024 + lc0;
                    u32x4 w; w.x = cvt_pk_bf16(x0[0], x0[1]); w.y = cvt_pk_bf16(x0[2], x0[3]); w.z = cvt_pk_bf16(x1[0], x1[1]); w.w = cvt_pk_bf16(x1[2], x1[3]);
                    *(u32x4*)rowp = w;
                    w.x = cvt_pk_bf16(y0[0], y0[1]); w.y = cvt_pk_bf16(y0[2], y0[3]); w.z = cvt_pk_bf16(y1[0], y1[1]); w.w = cvt_pk_bf16(y1[2], y1[3]);
                    *(u32x4*)(rowp + 32) = w; }
        }
    }
};
struct EpiSwiglu {
    static constexpr bool PERM = true, AFTER_DRAIN = false;
    bf16_t* O; int ldc;
    __device__ __forceinline__ void operator()(const f32x4 (&acc)[2][2][4][2], const Unit& u, int wr, int wc, int fr, int fq) const {
        const int row0 = u.pm * BM + wr * 64 + fr, col0 = u.pn * HALF + wc * 32 + 8 * fq;
#pragma unroll
        for (int ai = 0; ai < 2; ++ai)
#pragma unroll
            for (int m = 0; m < 4; ++m) { bf16_t* rowp = O + (size_t)(row0 + ai * HALF + m * 16) * ldc + col0;
                float h[8]; __builtin_amdgcn_sched_barrier(0);
#pragma unroll
                for (int n = 0; n < 2; ++n)
#pragma unroll
                    for (int i = 0; i < 4; ++i) { const float g = acc[ai][0][m][n][i], up = acc[ai][1][m][n][i];
                        h[4 * n + i] = g * __builtin_amdgcn_rcpf(1.0f + __builtin_amdgcn_exp2f(-1.4426950408889634f * g)) * up; }
                u32x4 w; w.x = cvt_pk_bf16(h[0], h[1]); w.y = cvt_pk_bf16(h[2], h[3]); w.z = cvt_pk_bf16(h[4], h[5]); w.w = cvt_pk_bf16(h[6], h[7]);
                *(u32x4*)rowp = w; }
    }
};
template <class Epi, class Sched, bool ALIGN_EPI = false, bool SP2 = false>
__device__ __forceinline__ void gemm_phase(PG8_LAS unsigned char* lds, const Gemm g, const Sched& S, const Epi& E) {
    int tid_o = threadIdx.x; asm volatile("" : "+v"(tid_o)); const int tid = tid_o, wid = __builtin_amdgcn_readfirstlane(tid >> 6), lane = tid & 63, wr = wid >> 2, wc = wid & 3, fr = lane & 15, fq = lane >> 4;
    const int K = g.K, nt = K / BK;
    unsigned voffA[2], voffB[2];
#pragma unroll
    for (int i = 0; i < 2; ++i) { int R, C; stage_rc(tid * 16 + i * 8192, R, C); const int Rb = Epi::PERM ? ((R & ~31) + perm32(R & 31)) : R;
        voffA[i] = (unsigned)(R * K + C) * 2u; voffB[i] = (unsigned)(Rb * K + C) * 2u; }
    const size_t kstep = (size_t)(BK * 2);
    const size_t hstep = (size_t)HALF * K * 2;
    const size_t tstep = 2 * hstep;
    const unsigned ldsw = (unsigned)wid * 1024u;
    const int aoff = lds_byte(wr * 64 + fr, fq * 8), boff = lds_byte(wc * 32 + fr, fq * 8);
#define PG8_SA(b, h) (((b) * 2 + (h)) * HTB)
#define PG8_SB(b, h) ((4 + (b) * 2 + (h)) * HTB)
#define PG8_STAGE(bufoff, gbase, voff) do { _Pragma("unroll") for (int _i = 0; _i < 2; ++_i) \
        __builtin_amdgcn_global_load_lds((const unsigned*)((const char*)(gbase) + (voff)[_i]), (PG8_LAS unsigned*)(lds + (bufoff) + ldsw + _i * 8192), 16, 0, 0); } while (0)
#define PG8_LDA(dst, b, h) do { _Pragma("unroll") for (int m = 0; m < 4; ++m) _Pragma("unroll") for (int k = 0; k < 2; ++k) dst[m][k] = *(const PG8_LAS bf16x8*)(lds + PG8_SA(b, h) + aoff + m * 2048 + k * 1024); } while (0)
#define PG8_LDB(dst, b, h) do { _Pragma("unroll") for (int n = 0; n < 2; ++n) _Pragma("unroll") for (int k = 0; k < 2; ++k) dst[n][k] = *(const PG8_LAS bf16x8*)(lds + PG8_SB(b, h) + boff + n * 2048 + k * 1024); } while (0)
#define PG8_MMA(ai, bj, At, Bt) do { __builtin_amdgcn_s_setprio(1); _Pragma("unroll") for (int m = 0; m < 4; ++m) _Pragma("unroll") for (int n = 0; n < 2; ++n) _Pragma("unroll") for (int k = 0; k < 2; ++k) \
        acc[ai][bj][m][n] = __builtin_amdgcn_mfma_f32_16x16x32_bf16(Bt[n][k], At[m][k], acc[ai][bj][m][n], 0, 0, 0); __builtin_amdgcn_s_setprio(0); } while (0)
#define PG8_WAIT_V(n) asm volatile("s_waitcnt vmcnt(" #n ")" ::: "memory")
#define PG8_WAIT_L(n) asm volatile("s_waitcnt lgkmcnt(" #n ")" ::: "memory")
#define PG8_BAR __builtin_amdgcn_s_barrier()
#define PG8_SCHED __builtin_amdgcn_sched_barrier(0)
    Unit cur, nxt; int ui = 0;
    if (!S.next(0, cur)) return;
    f32x4 acc[2][2][4][2];
#pragma unroll
    for (int a = 0; a < 2; ++a)
#pragma unroll
        for (int b = 0; b < 2; ++b)
#pragma unroll
            for (int m = 0; m < 4; ++m)
#pragma unroll
                for (int n = 0; n < 2; ++n) acc[a][b][m][n] = (f32x4){0.f, 0.f, 0.f, 0.f};
    bf16x8 At[4][2], B0[2][2], B1[2][2];
    const char* cA = (const char*)g.A + (size_t)cur.pm * tstep; const char* cB = (const char*)g.Bt + (size_t)cur.pn * tstep;
    S.a_ready(cur);
    if constexpr (SP2) {
        PG8_STAGE(PG8_SB(0, 0), cB, voffB); PG8_STAGE(PG8_SB(0, 1), cB + hstep, voffB); PG8_STAGE(PG8_SA(0, 0), cA, voffA); PG8_STAGE(PG8_SA(0, 1), cA + hstep, voffA);
        if (wr == 1) PG8_BAR;
        PG8_WAIT_V(2); PG8_BAR;
        PG8_STAGE(PG8_SB(1, 0), cB + kstep, voffB); PG8_STAGE(PG8_SA(1, 0), cA + kstep, voffA); PG8_STAGE(PG8_SB(1, 1), cB + hstep + kstep, voffB);
        PG8_WAIT_V(6); PG8_BAR;
    } else {
        PG8_STAGE(PG8_SB(0, 0), cB, voffB); PG8_STAGE(PG8_SA(0, 0), cA, voffA); PG8_STAGE(PG8_SB(0, 1), cB + hstep, voffB); PG8_STAGE(PG8_SA(0, 1), cA + hstep, voffA);
        if (wr == 1) PG8_BAR;
        PG8_WAIT_V(4); PG8_BAR;
        PG8_STAGE(PG8_SB(1, 0), cB + kstep, voffB); PG8_STAGE(PG8_SA(1, 0), cA + kstep, voffA); PG8_STAGE(PG8_SB(1, 1), cB + hstep + kstep, voffB);
        PG8_WAIT_V(6); PG8_BAR;
    }
    for (;;) {
        const bool has_next = S.next(ui + 1, nxt);
        const char* nA = has_next ? (const char*)g.A + (size_t)nxt.pm * tstep : cA; const char* nB = has_next ? (const char*)g.Bt + (size_t)nxt.pn * tstep : cB;
        for (int t = 0; t < nt; t += 2) {
            const bool last = (t == nt - 2);
            const char* a1 = cA + (size_t)(t + 1) * kstep;
            const char* a2 = last ? nA : cA + (size_t)(t + 2) * kstep; const char* b2 = last ? nB : cB + (size_t)(t + 2) * kstep;
            const char* a3 = a2 + kstep; const char* b3 = b2 + kstep;
            if (last && has_next) S.a_ready(nxt);
            if constexpr (SP2) {
            PG8_LDB(B0, 0, 0); PG8_LDB(B1, 0, 1); PG8_SCHED; PG8_LDA(At, 0, 0); PG8_STAGE(PG8_SA(1, 1), a1 + hstep, voffA);
            PG8_WAIT_V(8); PG8_WAIT_L(0); PG8_BAR; PG8_MMA(0, 0, At, B0); PG8_MMA(0, 1, At, B1); PG8_BAR; PG8_SCHED;
            PG8_LDA(At, 0, 1); PG8_STAGE(PG8_SB(0, 0), b2, voffB); PG8_STAGE(PG8_SB(0, 1), b2 + hstep, voffB); PG8_STAGE(PG8_SA(0, 0), a2, voffA);
            PG8_WAIT_V(8); PG8_WAIT_L(0); PG8_BAR; PG8_MMA(1, 0, At, B0); PG8_MMA(1, 1, At, B1); PG8_BAR; PG8_SCHED;
            PG8_LDB(B0, 1, 0); PG8_LDB(B1, 1, 1); PG8_SCHED; PG8_LDA(At, 1, 0); PG8_STAGE(PG8_SA(0, 1), a2 + hstep, voffA);
            PG8_WAIT_V(8); PG8_WAIT_L(0); PG8_BAR; PG8_MMA(0, 0, At, B0); PG8_MMA(0, 1, At, B1); PG8_BAR; PG8_SCHED;
            PG8_LDA(At, 1, 1); PG8_STAGE(PG8_SB(1, 0), b3, voffB); PG8_STAGE(PG8_SB(1, 1), b3 + hstep, voffB); PG8_STAGE(PG8_SA(1, 0), a3, voffA);
            PG8_WAIT_V(8); PG8_WAIT_L(0); PG8_BAR; PG8_MMA(1, 0, At, B0); PG8_MMA(1, 1, At, B1); PG8_BAR; PG8_SCHED;
            } else {
            PG8_LDB(B0, 0, 0); PG8_SCHED; PG8_LDA(At, 0, 0); PG8_STAGE(PG8_SA(1, 1), a1 + hstep, voffA);
            PG8_WAIT_L(8); PG8_BAR; PG8_WAIT_L(0); PG8_MMA(0, 0, At, B0); PG8_BAR; PG8_SCHED;
            PG8_LDB(B1, 0, 1); PG8_STAGE(PG8_SB(0, 0), b2, voffB);
            PG8_BAR; PG8_WAIT_L(0); PG8_MMA(0, 1, At, B1); PG8_BAR;
            PG8_LDA(At, 0, 1); PG8_STAGE(PG8_SA(0, 0), a2, voffA);
            PG8_BAR; PG8_WAIT_L(0); PG8_MMA(1, 0, At, B0); PG8_BAR; PG8_SCHED;
            PG8_STAGE(PG8_SB(0, 1), b2 + hstep, voffB);
            PG8_WAIT_V(6); PG8_BAR; PG8_MMA(1, 1, At, B1); PG8_BAR;
            PG8_LDB(B0, 1, 0); PG8_SCHED; PG8_LDA(At, 1, 0); PG8_STAGE(PG8_SA(0, 1), a2 + hstep, voffA);
            PG8_WAIT_L(8); PG8_BAR; PG8_WAIT_L(0); PG8_MMA(0, 0, At, B0); PG8_BAR; PG8_SCHED;
            PG8_LDB(B1, 1, 1); PG8_STAGE(PG8_SB(1, 0), b3, voffB);
            PG8_BAR; PG8_WAIT_L(0); PG8_MMA(0, 1, At, B1); PG8_BAR;
            PG8_LDA(At, 1, 1); PG8_STAGE(PG8_SA(1, 0), a3, voffA);
            PG8_BAR; PG8_WAIT_L(0); PG8_MMA(1, 0, At, B0); PG8_BAR; PG8_SCHED;
            PG8_STAGE(PG8_SB(1, 1), b3 + hstep, voffB);
            PG8_WAIT_V(6); PG8_BAR; PG8_MMA(1, 1, At, B1); PG8_BAR;
            }
        }
        if constexpr (ALIGN_EPI) { if (wr == 0) PG8_BAR; }
        if constexpr (!Epi::AFTER_DRAIN) { E(acc, cur, wr, wc, fr, fq); S.done(cur); }
        if (!has_next) break;
#pragma unroll
        for (int a = 0; a < 2; ++a)
#pragma unroll
            for (int b = 0; b < 2; ++b)
#pragma unroll
                for (int m = 0; m < 4; ++m)
#pragma unroll
                    for (int n = 0; n < 2; ++n) acc[a][b][m][n] = (f32x4){0.f, 0.f, 0.f, 0.f};
        cur = nxt; cA = nA; cB = nB; ++ui;
        if constexpr (ALIGN_EPI) { if (wr == 1) PG8_BAR; }
    }
    PG8_WAIT_V(0);
    if constexpr (!ALIGN_EPI) { if (wr == 0) PG8_BAR; }
    PG8_BAR;
    if constexpr (Epi::AFTER_DRAIN) { E.fused(acc, cur, wr, wc, fr, fq, lds, wid, lane); S.done(cur); }
#undef PG8_SA
#undef PG8_SB
#undef PG8_STAGE
#undef PG8_LDA
#undef PG8_LDB
#undef PG8_MMA
#undef PG8_WAIT_V
#undef PG8_WAIT_L
#undef PG8_BAR
#undef PG8_SCHED
}
}
constexpr int SEQ = 16384, NB = 2, T = NB * SEQ, DM = 1024, DFF = 2816, MEMT = 256;
constexpr int ZW = 1280;
constexpr float EPS = 1e-6f, LOG2E = 1.4426950408889634f;
constexpr int NTHREADS = 512;
constexpr int LDS_BYTES = 135168;

typedef unsigned short bf16;
typedef short bf16x8 __attribute__((ext_vector_type(8)));
typedef float f32x16 __attribute__((ext_vector_type(16)));
typedef float f32x4 __attribute__((ext_vector_type(4)));
typedef unsigned u32x4 __attribute__((ext_vector_type(4)));
typedef unsigned u32x2 __attribute__((ext_vector_type(2)));
#define LAS __attribute__((address_space(3)))

constexpr size_t MiB = 1u << 20;
constexpr size_t W_WIN = 0;
constexpr size_t W_WUQ = W_WIN + (size_t)ZW * 1024 * 2;
constexpr size_t W_WUKV = W_WUQ + (size_t)768 * 256 * 2;
constexpr size_t W_WO0 = W_WUKV + (size_t)1024 * 128 * 2;
constexpr size_t W_WQKV = W_WO0 + (size_t)1024 * 1024 * 2;
constexpr size_t W_WDO = W_WQKV + (size_t)3072 * 1024 * 2;
constexpr size_t W_WMQ = W_WDO + (size_t)1024 * 1024 * 2;
constexpr size_t W_WMKV = W_WMQ + (size_t)2 * 512 * 1024 * 2;
constexpr size_t W_WMO = W_WMKV + (size_t)2 * 1024 * 1024 * 2;
constexpr size_t W_WGU = W_WMO + (size_t)2 * 1024 * 512 * 2;
constexpr size_t W_WD = W_WGU + (size_t)2 * 5632 * 1024 * 2;
constexpr size_t W_END = W_WD + (size_t)2 * 1024 * 2816 * 2;
static_assert(W_END <= 55 * MiB, "weights");
constexpr size_t S_MN = 55 * MiB;
constexpr size_t S_MKV = 57 * MiB;
constexpr size_t S_MK = 59 * MiB;
constexpr size_t S_VTM = 60 * MiB;
constexpr size_t S_ROPE = 61 * MiB;
constexpr size_t S_LAM = 65 * MiB;
constexpr size_t A_XN = 66 * MiB;
constexpr size_t A_S = 130 * MiB;
constexpr size_t A_Z = A_S, A_QA = A_S + 80 * MiB, A_KA = A_S + 112 * MiB, A_VTA = A_S + 120 * MiB, A_CQN = A_S + 128 * MiB, A_CKVN = A_S + 144 * MiB,
                 A_QF = A_S + 152 * MiB, A_QB = A_S + 200 * MiB, A_KB = A_S + 248 * MiB, A_VTB = A_S + 296 * MiB, A_KV = A_XN, A_ATT = A_S;
constexpr size_t A_QM = A_S, A_MO = A_S + 32 * MiB, A_H = A_S;
constexpr size_t A_QKV = A_S, A_XH = A_S + 192 * MiB  , A_VTD = A_XN, A_O1 = A_S, A_O2 = A_S + 64 * MiB, A_DO = A_S + 128 * MiB;
constexpr size_t WS_NEED = A_S + 328 * MiB;

__device__ __forceinline__ unsigned f2bf(float f) { unsigned u = __builtin_bit_cast(unsigned, f); return (u + 0x7fffu + ((u >> 16) & 1u)) >> 16; }
typedef float f32x2 __attribute__((ext_vector_type(2))); typedef __bf16 bf16x2_t __attribute__((ext_vector_type(2)));
__device__ __forceinline__ unsigned pk2(float lo, float hi) { f32x2 v = {lo, hi}; bf16x2_t b = __builtin_convertvector(v, bf16x2_t); return __builtin_bit_cast(unsigned, b); }
__device__ __forceinline__ float bflo(unsigned w) { return __builtin_bit_cast(float, w << 16); }
__device__ __forceinline__ float bfhi(unsigned w) { return __builtin_bit_cast(float, w & 0xffff0000u); }
#define UNPK8(v, f) do { f[0] = bflo(v.x); f[1] = bfhi(v.x); f[2] = bflo(v.y); f[3] = bfhi(v.y); f[4] = bflo(v.z); f[5] = bfhi(v.z); f[6] = bflo(v.w); f[7] = bfhi(v.w); } while (0)
#define PACK8(v, f) do { v.x = pk2(f[0], f[1]); v.y = pk2(f[2], f[3]); v.z = pk2(f[4], f[5]); v.w = pk2(f[6], f[7]); } while (0)
__device__ __forceinline__ float shfl_xor_l(float v, int o, int lane) { return __builtin_bit_cast(float, __builtin_amdgcn_ds_bpermute((lane ^ o) << 2, __builtin_bit_cast(int, v))); }
__device__ __forceinline__ float wave_sum(float v, int lane) {
#pragma unroll
    for (int o = 1; o < 64; o <<= 1) v += shfl_xor_l(v, o, lane);
    return v;
}

struct Args { const float* in[32]; float* out; unsigned char* ws; int ph_lo, ph_hi; };

__device__ __forceinline__ void transpose_item(const float* W, int K, int N, bf16* WT, int mode, LAS float* scr, int item, int lane) {
    const int nblk = N / 32, kb = item / nblk, nb = item % nblk, k0 = 64 * kb, n0 = 32 * nb;
    const int drow0 = (mode == 0) ? n0 : (mode == 3) ? ((n0 < 2048) ? 256 * (n0 >> 8) + 128 * ((n0 >> 5) & 1) + 32 * ((n0 >> 6) & 3) : n0)
                                              : (256 * (n0 >> 7) + (n0 & 127) + (mode == 2 ? 128 : 0));
    f32x4 wv[8];
#pragma unroll
    for (int i = 0; i < 8; ++i) wv[i] = *(const f32x4*)(W + (size_t)(k0 + 8 * i + (lane >> 3)) * N + n0 + 4 * (lane & 7));
#pragma unroll
    for (int i = 0; i < 8; ++i) { LAS float* d = scr + (8 * i + (lane >> 3)) * 33 + 4 * (lane & 7); d[0] = wv[i].x; d[1] = wv[i].y; d[2] = wv[i].z; d[3] = wv[i].w; }
    asm volatile("s_waitcnt lgkmcnt(0)" ::: "memory");
    const int c = lane & 7;
#pragma unroll
    for (int j = 0; j < 4; ++j) { const int n = (lane >> 3) + 8 * j; const LAS float* s = scr + (8 * c) * 33 + n;
        u32x4 o; o.x = pk2(s[0 * 33], s[1 * 33]); o.y = pk2(s[2 * 33], s[3 * 33]); o.z = pk2(s[4 * 33], s[5 * 33]); o.w = pk2(s[6 * 33], s[7 * 33]);
        *(u32x4*)(WT + (size_t)(drow0 + n) * K + k0 + 8 * c) = o; }
    asm volatile("s_waitcnt lgkmcnt(0)" ::: "memory");
}


__device__ __forceinline__ float chunk_ss(const u32x4 v) { float f[8]; UNPK8(v, f); float s = 0.f;
#pragma unroll
    for (int i = 0; i < 8; ++i) s += f[i] * f[i];
    return s; }
__device__ __forceinline__ u32x4 chunk_scale(const u32x4 v, float r, const float* g) { float f[8]; UNPK8(v, f);
    const f32x4 g0 = ((const f32x4*)g)[0], g1 = ((const f32x4*)g)[1];
    f[0] *= r * g0.x; f[1] *= r * g0.y; f[2] *= r * g0.z; f[3] *= r * g0.w; f[4] *= r * g1.x; f[5] *= r * g1.y; f[6] *= r * g1.z; f[7] *= r * g1.w;
    u32x4 o; PACK8(o, f); return o; }

__device__ __forceinline__ void norm_row_1024(const float* xrow, const float* gain, bf16* orow, int lane) {
    const f32x4* xr = (const f32x4*)xrow + lane; const f32x4* gr = (const f32x4*)gain + lane;
    f32x4 v[4]; float s = 0.f;
#pragma unroll
    for (int j = 0; j < 4; ++j) { v[j] = xr[64 * j]; s += (v[j].x * v[j].x + v[j].y * v[j].y) + (v[j].z * v[j].z + v[j].w * v[j].w); }
    const float rstd = 1.0f / sqrtf(wave_sum(s, lane) * (1.f / 1024.f) + EPS);
    unsigned long long* o8 = (unsigned long long*)orow + lane;
#pragma unroll
    for (int j = 0; j < 4; ++j) { const f32x4 g = gr[64 * j];
        o8[64 * j] = (unsigned long long)pk2(v[j].x * rstd * g.x, v[j].y * rstd * g.y) | ((unsigned long long)pk2(v[j].z * rstd * g.z, v[j].w * rstd * g.w) << 32); }
}
__device__ __forceinline__ void norm_row_1024_h(const bf16* xrow, const float* gain, bf16* orow, int lane) {
    u32x4 v[2]; float s = 0.f;
#pragma unroll
    for (int j = 0; j < 2; ++j) { v[j] = ((const u32x4*)xrow)[lane + 64 * j]; s += chunk_ss(v[j]); }
    const float rstd = 1.0f / sqrtf(wave_sum(s, lane) * (1.f / 1024.f) + EPS);
#pragma unroll
    for (int j = 0; j < 2; ++j) ((u32x4*)orow)[lane + 64 * j] = chunk_scale(v[j], rstd, gain + 8 * (lane + 64 * j));
}
__device__ __forceinline__ void norm_phase_h(const bf16* X, const float* gain, bf16* XN, int gw, int NGW, int lane) {
    for (int m = gw; m < T; m += NGW) norm_row_1024_h(X + (size_t)m * DM, gain, XN + (size_t)m * DM, lane);
}
__device__ __forceinline__ void norm_phase(const float* X, const float* gain, bf16* XN, int gw, int NGW, int lane) {
    for (int m = gw; m < T; m += NGW) norm_row_1024(X + (size_t)m * DM, gain, XN + (size_t)m * DM, lane);
}

template <int N> __device__ __forceinline__ void rms_group(const bf16* src, bf16* dst, const float* gain, float oscale) {
    float ss = 0.f;
#pragma unroll 4
    for (int c = 0; c < N / 8; ++c) { const u32x4 v = ((const u32x4*)src)[c]; float f[8]; UNPK8(v, f);
#pragma unroll
        for (int i = 0; i < 8; ++i) ss += f[i] * f[i]; }
    const float r = (1.0f / sqrtf(ss * (1.f / N) + EPS)) * oscale;
#pragma unroll 4
    for (int c = 0; c < N / 8; ++c) { const u32x4 v = ((const u32x4*)src)[c]; float f[8]; UNPK8(v, f);
        const f32x4 g0 = ((const f32x4*)gain)[2 * c], g1 = ((const f32x4*)gain)[2 * c + 1];
        f[0] *= r * g0.x; f[1] *= r * g0.y; f[2] *= r * g0.z; f[3] *= r * g0.w; f[4] *= r * g1.x; f[5] *= r * g1.y; f[6] *= r * g1.z; f[7] *= r * g1.w;
        u32x4 o; PACK8(o, f); ((u32x4*)dst)[c] = o; }
}

__device__ __forceinline__ void mla_head_item(const bf16* srcA, const bf16* srcB, bf16* dst, const float* gain, float oscale, const float2* rope) {
    float ss = 0.f;
#pragma unroll
    for (int c = 0; c < 8; ++c) { const u32x4 v = ((const u32x4*)srcA)[c]; float f[8]; UNPK8(v, f);
#pragma unroll
        for (int i = 0; i < 8; ++i) ss += f[i] * f[i]; }
#pragma unroll
    for (int c = 0; c < 4; ++c) { const u32x4 v = ((const u32x4*)srcB)[c]; float f[8]; UNPK8(v, f);
#pragma unroll
        for (int i = 0; i < 8; ++i) ss += f[i] * f[i]; }
    const float r = (1.0f / sqrtf(ss * (1.f / 96.f) + EPS)) * oscale;
#pragma unroll
    for (int c = 0; c < 8; ++c) { const u32x4 v = ((const u32x4*)srcA)[c]; float f[8]; UNPK8(v, f);
#pragma unroll
        for (int i = 0; i < 8; ++i) f[i] *= r * gain[8 * c + i];
        u32x4 o; PACK8(o, f); ((u32x4*)dst)[c] = o; }
#pragma unroll
    for (int hc = 0; hc < 2; ++hc) {
        const u32x4 v1 = ((const u32x4*)srcB)[hc], v2 = ((const u32x4*)srcB)[2 + hc]; float x1[8], x2[8], o1[8], o2[8]; UNPK8(v1, x1); UNPK8(v2, x2);
#pragma unroll
        for (int i = 0; i < 8; ++i) { const float a = x1[i] * r * gain[64 + 8 * hc + i], b = x2[i] * r * gain[80 + 8 * hc + i]; const float2 cs = rope[8 * hc + i];
            o1[i] = a * cs.x - b * cs.y; o2[i] = b * cs.x + a * cs.y; }
        u32x4 w1, w2; PACK8(w1, o1); PACK8(w2, o2); ((u32x4*)dst)[8 + hc] = w1; ((u32x4*)dst)[10 + hc] = w2; }
}

template <int NC>
__device__ __forceinline__ void transpose_tiles(LAS unsigned char* lds, const bf16* src, int pitch, int cbase, int cstride, int nct, bf16* dst, int W, int slen, int nrows, int bid_, int G_, int tid) {
    constexpr int LS = NC * 64 + 8;
    const int nsc = nct / NC, nst = (nrows / 64) * nsc;
    LAS bf16* tl = (LAS bf16*)lds;
    for (int st = bid_; st < nst; st += G_) {
        const int rt = st / nsc, sc = st % nsc, r0 = rt * 64, b = r0 / slen, t0 = r0 % slen;
        { const int tok = tid >> 3, ch = tid & 7; u32x4 v[NC];
#pragma unroll
          for (int i = 0; i < NC; ++i) v[i] = *(const u32x4*)(src + (size_t)(r0 + tok) * pitch + cbase + (sc * NC + i) * cstride + ch * 8);
#pragma unroll
          for (int i = 0; i < NC; ++i) *(LAS u32x4*)(tl + tok * LS + i * 64 + ch * 8) = v[i]; }
        __syncthreads();
        { const int col = tid >> 3, tc = tid & 7;
#pragma unroll
          for (int i = 0; i < NC; ++i) { unsigned w[4];
#pragma unroll
              for (int k = 0; k < 4; ++k) { const unsigned lo = tl[(tc * 8 + 2 * k) * LS + i * 64 + col], hi = tl[(tc * 8 + 2 * k + 1) * LS + i * 64 + col]; w[k] = lo | (hi << 16); }
              u32x4 o; o.x = w[0]; o.y = w[1]; o.z = w[2]; o.w = w[3];
              *(u32x4*)(dst + ((size_t)b * W + (sc * NC + i) * 64 + col) * slen + t0 + tc * 8) = o; } }
        __syncthreads();
    }
}

constexpr int AF_CAUSAL = 1, AF_WINDOW = 2, AF_ALIBI = 4, AF_SINK = 8, AF_QNORM = 16, AF_ROBUST = 32, AF_REV = 64;
#define MX3(a, b, c) __builtin_fmaxf(__builtin_fmaxf((a), (b)), (c))
constexpr int SWA_W = 128;
__device__ __forceinline__ bf16x8 pack_bf16x8(const f32x16& p, int base) {
    u32x4 w; w.x = pk2(p[base + 0], p[base + 1]); w.y = pk2(p[base + 2], p[base + 3]); w.z = pk2(p[base + 4], p[base + 5]); w.w = pk2(p[base + 6], p[base + 7]);
    return __builtin_bit_cast(bf16x8, w);
}
template <int DQK, int DV, int FLAGS, int qp, int kp, int vts, int op>
__device__ __forceinline__ void attn_unit(LAS unsigned char* lds, const bf16* Q, const bf16* K, const bf16* VT, bf16* O,
                                          int q0, int kt_lo, int kt_hi, float slope2, float sink2, const float* qgain, float qscale) {
    constexpr int KROW = DQK * 2 + 16, VROW = 144, KT_BYTES = 64 * KROW, VT_BYTES = DV * VROW, BUF = KT_BYTES + VT_BYTES;
    constexpr int KC = DQK / 8, KCH = 64 * KC, VCH = DV * 8, KPT = (KCH + NTHREADS - 1) / NTHREADS, VPT = VCH / NTHREADS, ND0 = DQK / 16, NDB = DV / 32;
    static_assert(2 * BUF <= LDS_BYTES, "attention LDS");
    int tid_o = threadIdx.x; asm volatile("" : "+v"(tid_o));
    const int tid = tid_o, lane = tid & 63, r32 = lane & 31, hi = lane >> 5; const int wave = __builtin_amdgcn_readfirstlane(tid >> 6);
    bf16x8 qr[ND0];
    { const bf16* qrow = Q + (size_t)(32 * wave + r32) * qp + 8 * hi;
#pragma unroll
      for (int d0 = 0; d0 < ND0; ++d0) qr[d0] = *(const bf16x8*)(qrow + 16 * d0);
      if (FLAGS & AF_QNORM) {
          float ss = 0.f;
#pragma unroll
          for (int d0 = 0; d0 < ND0; ++d0) { const u32x4 v = __builtin_bit_cast(u32x4, qr[d0]); float f[8]; UNPK8(v, f);
#pragma unroll
              for (int i = 0; i < 8; ++i) ss += f[i] * f[i]; }
          ss += shfl_xor_l(ss, 32, lane);
          const float r = (1.0f / sqrtf(ss * (1.f / DQK) + EPS)) * qscale;
#pragma unroll
          for (int d0 = 0; d0 < ND0; ++d0) { const u32x4 v = __builtin_bit_cast(u32x4, qr[d0]); float f[8]; UNPK8(v, f);
#pragma unroll
              for (int i = 0; i < 8; ++i) f[i] *= r * qgain[16 * d0 + 8 * hi + i];
              u32x4 o; PACK8(o, f); qr[d0] = __builtin_bit_cast(bf16x8, o); }
      } }
    const int qpos = q0 + 32 * wave + r32, qmin_w = q0 + 32 * wave, qmax_w = qmin_w + 31;
    f32x16 o[NDB];
#pragma unroll
    for (int d = 0; d < NDB; ++d)
#pragma unroll
        for (int r = 0; r < 16; ++r) o[d][r] = 0.f;
    float m = (FLAGS & AF_ROBUST) ? -1e30f : 0.f, l = 0.f;
    f32x16 negm;
#pragma unroll
    for (int r = 0; r < 16; ++r) negm[r] = 0.f;
    u32x4 kreg[KPT], vreg[VPT];
    unsigned kgo[KPT], vgo[VPT], klo[KPT], vlo[VPT];
#pragma unroll
    for (int i = 0; i < KPT; ++i) { const int c = tid + i * NTHREADS; const int row = c / KC, cc = c % KC; kgo[i] = (unsigned)(row * kp + cc * 8) * 2u; klo[i] = (unsigned)(row * KROW + cc * 16); }
#pragma unroll
    for (int i = 0; i < VPT; ++i) { const int c = tid + i * NTHREADS; const int d = c >> 3, cc = c & 7; vgo[i] = (unsigned)(d * vts + cc * 8) * 2u; vlo[i] = (unsigned)(KT_BYTES + d * VROW + cc * 16); }
#define ATT_GLOAD(t) do { const char* kt_ = (const char*)(K + (size_t)(t) * 64 * kp); const char* vt_ = (const char*)(VT + (size_t)(t) * 64); \
        _Pragma("unroll") for (int i = 0; i < KPT; ++i) { if (KCH % NTHREADS == 0 || tid + i * NTHREADS < KCH) kreg[i] = *(const u32x4*)(kt_ + kgo[i]); } \
        _Pragma("unroll") for (int i = 0; i < VPT; ++i) vreg[i] = *(const u32x4*)(vt_ + vgo[i]); } while (0)
#define ATT_LSTORE(buf) do { LAS unsigned char* b_ = lds + (buf) * BUF; \
        _Pragma("unroll") for (int i = 0; i < KPT; ++i) { if (KCH % NTHREADS == 0 || tid + i * NTHREADS < KCH) *(LAS u32x4*)(b_ + klo[i]) = kreg[i]; } \
        _Pragma("unroll") for (int i = 0; i < VPT; ++i) *(LAS u32x4*)(b_ + vlo[i]) = vreg[i]; } while (0)
    ATT_GLOAD((FLAGS & AF_REV) ? kt_hi - 1 : kt_lo); ATT_LSTORE(0);
    __syncthreads();
    bool started = false;
    const int prow = (r32 & ~12) | ((r32 & 4) << 1) | ((r32 & 8) >> 1);
    const int ntile = kt_hi - kt_lo;
    for (int it = 0; it < ntile; ++it) {
        const int t = (FLAGS & AF_REV) ? kt_hi - 1 - it : kt_lo + it;
        const int cur = it & 1;
        const bool more = (it + 1 < ntile);
        const int kv0 = t * 64;
        bool skip = false;
        if (FLAGS & AF_CAUSAL) skip = skip || (kv0 > qmax_w);
        if (FLAGS & AF_WINDOW) skip = skip || (kv0 + 63 < qmin_w - (SWA_W - 1));
        if (!skip) {
            const LAS unsigned char* kb = lds + cur * BUF + prow * KROW + 16 * hi;
            const LAS unsigned char* vb = lds + cur * BUF + KT_BYTES + r32 * VROW + 16 * hi;
            f32x16 p0, p1;
            bf16x8 kf[2][4];
#pragma unroll
            for (int i = 0; i < 2; ++i) { kf[0][2 * i] = *(const LAS bf16x8*)(kb + i * 32); kf[0][2 * i + 1] = *(const LAS bf16x8*)(kb + 32 * KROW + i * 32); }
            const int nrel = qpos - kv0 - 8 * hi;
            if (FLAGS & AF_ALIBI) { const float ab = -slope2 * (float)nrel - ((FLAGS & AF_ROBUST) ? 0.f : m);
#pragma unroll
                for (int r = 0; r < 16; ++r) { const float c = (float)(16 * (r >> 3) + (r & 7)); p0[r] = __builtin_fmaf(slope2, c, ab); p1[r] = __builtin_fmaf(slope2, c + 32.f, ab); }
            } else if (FLAGS & AF_ROBUST) {
#pragma unroll
                for (int r = 0; r < 16; ++r) { p0[r] = 0.f; p1[r] = 0.f; }
            } else { p0 = negm; p1 = negm; }
            __builtin_amdgcn_sched_barrier(0);
#pragma unroll
            for (int c = 0; c < ND0 / 2; ++c) {
                if (c + 1 < ND0 / 2) {
#pragma unroll
                    for (int i = 0; i < 2; ++i) { kf[(c + 1) & 1][2 * i] = *(const LAS bf16x8*)(kb + (2 * c + 2 + i) * 32); kf[(c + 1) & 1][2 * i + 1] = *(const LAS bf16x8*)(kb + 32 * KROW + (2 * c + 2 + i) * 32); }
                }
#pragma unroll
                for (int i = 0; i < 2; ++i) {
                    p0 = __builtin_amdgcn_mfma_f32_32x32x16_bf16(kf[c & 1][2 * i], qr[2 * c + i], p0, 0, 0, 0);
                    p1 = __builtin_amdgcn_mfma_f32_32x32x16_bf16(kf[c & 1][2 * i + 1], qr[2 * c + i], p1, 0, 0, 0);
                }
                __builtin_amdgcn_sched_barrier(0);
            }
            if (more) ATT_GLOAD((FLAGS & AF_REV) ? t - 1 : t + 1);
            bf16x8 vf[2][4];
#pragma unroll
            for (int ks = 0; ks < 4; ++ks) vf[0][ks] = *(const LAS bf16x8*)(vb + ks * 32);
            __builtin_amdgcn_sched_barrier(0);
            bool need_mask = false;
            if (FLAGS & AF_CAUSAL) need_mask = need_mask || (kv0 + 63 > qmin_w);
            if (FLAGS & AF_WINDOW) need_mask = need_mask || (kv0 < qmax_w - (SWA_W - 1));
            if (need_mask) {
#pragma unroll
                for (int r = 0; r < 16; ++r) { const int c = 16 * (r >> 3) + (r & 7);
                    bool m0 = false, m1 = false;
                    if (FLAGS & AF_CAUSAL) { m0 = m0 || (c > nrel); m1 = m1 || (c + 32 > nrel); }
                    if (FLAGS & AF_WINDOW) { m0 = m0 || (c <= nrel - SWA_W); m1 = m1 || (c + 32 <= nrel - SWA_W); }
                    if (m0) p0[r] = -INFINITY; if (m1) p1[r] = -INFINITY; }
            }
            float mx;
            { float a = MX3(p0[0], p0[1], p1[0]), b = MX3(p0[2], p0[3], p1[1]); a = MX3(a, p1[2], p1[3]);
#pragma unroll
              for (int r = 4; r < 16; r += 4) { a = MX3(a, p0[r], p0[r + 1]); b = MX3(b, p0[r + 2], p0[r + 3]); a = MX3(a, p1[r], p1[r + 1]); b = MX3(b, p1[r + 2], p1[r + 3]); }
              mx = __builtin_fmaxf(a, b);
              mx = __builtin_fmaxf(mx, shfl_xor_l(mx, 32, lane)); }
            if (FLAGS & AF_ROBUST) {
                if (__any(mx > m + 8.0f)) {
                    const float mn = fmaxf(m, mx), alpha = __builtin_amdgcn_exp2f(m - mn);
                    l *= alpha; m = mn;
#pragma unroll
                    for (int d = 0; d < NDB; ++d)
#pragma unroll
                        for (int r = 0; r < 16; ++r) o[d][r] *= alpha;
                }
#pragma unroll
                for (int r = 0; r < 16; ++r) { p0[r] -= m; p1[r] -= m; }
            } else {
                if (!started) {
                    started = true;
                    m = mx;
#pragma unroll
                    for (int r = 0; r < 16; ++r) { p0[r] -= mx; p1[r] -= mx; }
                    if (!(FLAGS & AF_ALIBI)) {
#pragma unroll
                        for (int r = 0; r < 16; ++r) negm[r] = -m;
                    }
                } else if (__any(mx > 64.0f)) {
                    const float dl = __builtin_fmaxf(mx, 0.f), alpha = __builtin_amdgcn_exp2f(-dl);
                    m += dl; l *= alpha;
#pragma unroll
                    for (int r = 0; r < 16; ++r) { p0[r] -= dl; p1[r] -= dl; }
#pragma unroll
                    for (int d = 0; d < NDB; ++d)
#pragma unroll
                        for (int r = 0; r < 16; ++r) o[d][r] *= alpha;
                    if (!(FLAGS & AF_ALIBI)) {
#pragma unroll
                        for (int r = 0; r < 16; ++r) negm[r] = -m;
                    }
                }
            }
            f32x2 rs2 = {0.f, 0.f};
#pragma unroll
            for (int r = 0; r < 16; ++r) { p0[r] = __builtin_amdgcn_exp2f(p0[r]); p1[r] = __builtin_amdgcn_exp2f(p1[r]); }
#pragma unroll
            for (int r = 0; r < 16; r += 2) { rs2 += (f32x2){p0[r], p0[r + 1]}; rs2 += (f32x2){p1[r], p1[r + 1]}; }
            l += rs2.x + rs2.y;
            bf16x8 pf[4];
            pf[0] = pack_bf16x8(p0, 0); pf[1] = pack_bf16x8(p0, 8); pf[2] = pack_bf16x8(p1, 0); pf[3] = pack_bf16x8(p1, 8);
            __builtin_amdgcn_sched_barrier(0);
#pragma unroll
            for (int d = 0; d < NDB; ++d) {
                if (d + 1 < NDB) {
#pragma unroll
                    for (int ks = 0; ks < 4; ++ks) vf[(d + 1) & 1][ks] = *(const LAS bf16x8*)(vb + (d + 1) * 32 * VROW + ks * 32);
                }
#pragma unroll
                for (int ks = 0; ks < 4; ++ks) o[d] = __builtin_amdgcn_mfma_f32_32x32x16_bf16(vf[d & 1][ks], pf[ks], o[d], 0, 0, 0);
                __builtin_amdgcn_sched_barrier(0);
            }
        }
        if (skip && more) ATT_GLOAD((FLAGS & AF_REV) ? t - 1 : t + 1);
        if (more) ATT_LSTORE(cur ^ 1);
        __syncthreads();
    }
#undef ATT_GLOAD
#undef ATT_LSTORE
    float lt = l + shfl_xor_l(l, 32, lane);
    if (FLAGS & AF_SINK) lt += __builtin_amdgcn_exp2f(sink2 - m);
    const float inv = 1.0f / lt;
    bf16* orow = O + (size_t)(32 * wave + r32) * op + 4 * hi;
#pragma unroll
    for (int d = 0; d < NDB; ++d)
#pragma unroll
        for (int g = 0; g < 4; ++g) {
            u32x2 w; w.x = pk2(o[d][4 * g] * inv, o[d][4 * g + 1] * inv); w.y = pk2(o[d][4 * g + 2] * inv, o[d][4 * g + 3] * inv);
            *(u32x2*)(orow + 32 * d + 8 * g) = w;
        }
}

__device__ __forceinline__ void causal_slot(int j, int NCPC, int& combo, int& qb) {
    const int i = j >> 8, c = j & 255, vc = (c & 7) * 32 + (c >> 3);
    combo = vc / NCPC; const int s = vc % NCPC, g = i >> 1;
    qb = (i & 1) ? (2 * NCPC * (g + 1) - 1 - s) : (2 * NCPC * g + s);
}

template <class Epi> __device__ __forceinline__ void run_gemm(LAS unsigned char* lds, const bf16* A, const bf16* Bt, int M, int N, int K, const Epi& E, int cid) {
    pg8::Gemm g{A, Bt, M, N, K}; pg8::StaticOrder S; S.init(M, N, (int)gridDim.x, cid);
#ifdef NO_RESID
    if constexpr (__is_same(Epi, pg8::EpiResid)) return;
#endif
#ifdef NO_SWIGLU
    if constexpr (__is_same(Epi, pg8::EpiSwiglu)) return;
#endif
#ifdef NO_STORE
    if constexpr (__is_same(Epi, pg8::EpiStore)) return;
#endif
#ifndef NO_GEMM
    pg8::gemm_phase<Epi, pg8::StaticOrder, true, true>(lds, g, S, E);
#endif
}

#define XB_TMO      128
#define XB_XCNT(j)  (256  + 64 * (j))
#define XB_XSUB(j)  (1280 + 64 * (j))
#define XB_XGEN(j)  (2304 + 64 * (j))
#define XB_TOP      3328
#define XB_TOPGEN   3392
#define XCD_BAR_WORDS 3456
#define XB_SPIN_CAP (1u << 18)

__device__ __forceinline__ unsigned xb_ld(unsigned* p)              { return __hip_atomic_load(p, __ATOMIC_RELAXED, __HIP_MEMORY_SCOPE_AGENT); }
__device__ __forceinline__ unsigned xb_add(unsigned* p, unsigned v) { return __hip_atomic_fetch_add(p, v, __ATOMIC_RELAXED, __HIP_MEMORY_SCOPE_AGENT); }
__device__ __forceinline__ unsigned xb_xcc_id() { return (unsigned)__builtin_amdgcn_s_getreg((3 << 11) | 20) & 0xFu; }
#define XB_SPIN(cond, bar) do { unsigned _sp = 0; while (cond) { __builtin_amdgcn_s_sleep(1); \
    if ((++_sp & 255u) == 0u) { if (xb_ld(&(bar)[XB_TMO])) break; if (_sp > XB_SPIN_CAP) { atomicAdd(&(bar)[XB_TMO], 1u); break; } } } } while (0)

struct XcdBarrier {
    unsigned* bar; unsigned x;
    volatile LAS unsigned* st;
};

__device__ __forceinline__ XcdBarrier xcd_barrier_post(unsigned* bar, volatile LAS unsigned* st) {
    XcdBarrier b; b.bar = bar; b.x = xb_xcc_id(); b.st = st;
    if (threadIdx.x == 0) (void)xb_add(&bar[XB_XCNT(b.x)], 1u);
    return b;
}
__device__ __forceinline__ void xcd_barrier_complete(unsigned* bar, unsigned x, unsigned& nloc, unsigned& nx) {
    const unsigned G = gridDim.x * gridDim.y * gridDim.z;
    unsigned sum, cnt, mine, sp = 0u;
    for (;;) {
        sum = 0u; cnt = 0u; mine = 0u;
#pragma unroll
        for (unsigned j = 0; j < 16; ++j) { const unsigned c = xb_ld(&bar[XB_XCNT(j)]); sum += c; cnt += (c > 0u) ? 1u : 0u; mine = (j == x) ? c : mine; }
        if (sum == G) break;
        __builtin_amdgcn_s_sleep(1);
        if ((++sp & 255u) == 0u) { if (xb_ld(&bar[XB_TMO])) break; if (sp > XB_SPIN_CAP) { atomicAdd(&bar[XB_TMO], 1u); break; } }
    }
    nloc = mine > 0u ? mine : 1u; nx = cnt > 0u ? cnt : 1u;
}

__device__ __forceinline__ void xcd_barrier(const XcdBarrier& b) {
    asm volatile("s_waitcnt vmcnt(0)" ::: "memory");
    __syncthreads();
    if (threadIdx.x == 0) {
        unsigned* bar = b.bar;
        __builtin_amdgcn_s_waitcnt(0);
        unsigned nloc = b.st[0], nx = b.st[1];
        if (nloc == 0u) { xcd_barrier_complete(bar, b.x, nloc, nx); b.st[0] = nloc; b.st[1] = nx; }
        const unsigned old = xb_add(&bar[XB_XSUB(b.x)], 1u);
        const unsigned gen = old / nloc;
        if (old + 1u == (gen + 1u) * nloc) {
            __builtin_amdgcn_fence(__ATOMIC_RELEASE, "agent");
            asm volatile("s_waitcnt vmcnt(0)" ::: "memory");
            const unsigned og = xb_add(&bar[XB_TOP], 1u);
            const unsigned tg = og / nx;
            if (og + 1u == (tg + 1u) * nx) xb_add(&bar[XB_TOPGEN], 1u);
            else XB_SPIN(xb_ld(&bar[XB_TOPGEN]) == tg, bar);
            __builtin_amdgcn_fence(__ATOMIC_ACQUIRE, "agent");
            xb_add(&bar[XB_XGEN(b.x)], 1u);
            asm volatile("s_waitcnt vmcnt(0)" ::: "memory");
        } else {
            XB_SPIN(xb_ld(&bar[XB_XGEN(b.x)]) == gen, bar);
            __builtin_amdgcn_fence(__ATOMIC_ACQUIRE, "agent");
            asm volatile("s_waitcnt vmcnt(0)" ::: "memory");
        }
    }
    __syncthreads();
}

constexpr size_t S_CTL = 65 * MiB + 65536;
constexpr int LDS_ST_OFF = 131072 + 64;
constexpr int NPHASE = 27;
__global__ void __launch_bounds__(NTHREADS, 2) mega_fwd(Args args) {
#define INP(i) (*(const float* const volatile __attribute__((address_space(4)))*)((const __attribute__((address_space(4))) char*)__builtin_amdgcn_kernarg_segment_ptr() + 8 * (i)))
    extern __shared__ __attribute__((aligned(16))) unsigned char lds_raw[];
    LAS unsigned char* lds = (LAS unsigned char*)lds_raw;
#define G ((int)gridDim.x)
#define bid ((int)blockIdx.x)
#define NGW (G * 8)
#define NGT (G * NTHREADS)
#define PHASE_IDS int tid = threadIdx.x; asm volatile("" : "+v"(tid)); const int lane = tid & 63; const int wave = __builtin_amdgcn_readfirstlane(tid >> 6); const int gw = bid * 8 + wave, gt = bid * NTHREADS + tid; (void)lane; (void)gw; (void)gt
    unsigned char* ws = args.ws;
    const int lo = args.ph_lo, hi_ph = args.ph_hi;
#ifndef DUPMASK
#define DUPMASK 0u
#endif
#define IN(k) (lo <= (k) && (k) < hi_ph)
#define REP(k) for (int rep_ = 0; rep_ < 1 + (int)((DUPMASK >> (k)) & 1u); ++rep_)
#if MK_MULTI
#define SEAM(k) do { } while (0)
#else
#define SEAM(k) do { if (IN(k) && IN((k) + 1)) { xcd_barrier(xbar); } } while (0)
#endif
#if !MK_MULTI
    if (threadIdx.x < 2) ((volatile LAS unsigned*)(lds + LDS_ST_OFF))[threadIdx.x] = 0u;
    __syncthreads();
    const XcdBarrier xbar = xcd_barrier_post((unsigned*)(ws + S_CTL), (volatile LAS unsigned*)(lds + LDS_ST_OFF));
    if (args.ph_lo < 0) cg::this_grid().sync();
#endif
    const float* x = INP(0); const float* mem = INP(1); const int* positions = (const int*)INP(2);
    bf16* XH = (bf16*)(ws + A_XH);
    bf16* QDb = (bf16*)args.out; bf16* KDb = (bf16*)args.out + (size_t)T * 1024;
    bf16* XN = (bf16*)(ws + A_XN);

    REP(0) if (IN(0)) {
        PHASE_IDS;
        LAS float* scr = (LAS float*)(lds + wave * 8704);
        for (int job = 0; job < 18; ++job) {
            const float* W; int K, N, mode = 0; bf16* dst;
            switch (job) {
                case 0: W = INP(4); K = 1024; N = 1184; dst = (bf16*)(ws + W_WIN); break;
                case 1: W = INP(10); K = 256; N = 768; dst = (bf16*)(ws + W_WUQ); break;
                case 2: W = INP(11); K = 128; N = 1024; dst = (bf16*)(ws + W_WUKV); break;
                case 3: W = INP(14); K = 1024; N = 1024; dst = (bf16*)(ws + W_WO0); break;
                case 4: W = INP(15); K = 1024; N = 3072; mode = 3; dst = (bf16*)(ws + W_WQKV); break;
                case 5: W = INP(20); K = 1024; N = 1024; dst = (bf16*)(ws + W_WDO); break;
                case 6: case 7: W = INP(23) + (size_t)(job - 6) * 1024 * 512; K = 1024; N = 512; dst = (bf16*)(ws + W_WMQ) + (size_t)(job - 6) * 512 * 1024; break;
                case 8: case 9: W = INP(24) + (size_t)(job - 8) * 1024 * 1024; K = 1024; N = 1024; dst = (bf16*)(ws + W_WMKV) + (size_t)(job - 8) * 1024 * 1024; break;
                case 10: case 11: W = INP(27) + (size_t)(job - 10) * 512 * 1024; K = 512; N = 1024; dst = (bf16*)(ws + W_WMO) + (size_t)(job - 10) * 1024 * 512; break;
                case 12: case 13: W = INP(29) + (size_t)(job - 12) * 1024 * DFF; K = 1024; N = DFF; mode = 1; dst = (bf16*)(ws + W_WGU) + (size_t)(job - 12) * 5632 * 1024; break;
                case 14: case 15: W = INP(30) + (size_t)(job - 14) * 1024 * DFF; K = 1024; N = DFF; mode = 2; dst = (bf16*)(ws + W_WGU) + (size_t)(job - 14) * 5632 * 1024; break;
                default: W = INP(31) + (size_t)(job - 16) * DFF * 1024; K = DFF; N = 1024; dst = (bf16*)(ws + W_WD) + (size_t)(job - 16) * 1024 * DFF; break;
            }
            const int nitems = (K / 64) * (N / 32);
            for (int it = gw; it < nitems; it += NGW) transpose_item(W, K, N, dst, mode, scr, it, lane);
        }
        { u32x4* z = (u32x4*)((bf16*)(ws + W_WIN) + (size_t)1184 * 1024); const u32x4 zero = {0u, 0u, 0u, 0u};
          for (int i = gt; i < 96 * 1024 / 8; i += NGT) z[i] = zero; }
        norm_phase(x, INP(3), XN, gw, NGW, lane);
        for (int it = gw; it < 2 * 512; it += NGW) { const int ly = it >> 9, r = it & 511;
            norm_row_1024(mem + (size_t)r * DM, INP(22) + ly * DM, (bf16*)(ws + S_MN) + ((size_t)ly * 512 + r) * DM, lane); }
        { float2* rope = (float2*)(ws + S_ROPE);
          for (int e = gt; e < T * 16; e += NGT) { const int row = e >> 4, i = e & 15;
              const float b4 = (i & 3) == 0 ? 1.0f : (i & 3) == 1 ? 0.5623413251903491f : (i & 3) == 2 ? 0.31622776601683794f : 0.1778279410038923f;
              const float p10 = (i >> 2) == 0 ? 1.0f : (i >> 2) == 1 ? 0.1f : (i >> 2) == 2 ? 0.01f : 0.001f;
              const float inv = (float)((double)b4 * (double)p10);
              const float ang = (float)positions[row] * inv;
              double rev = (double)ang * 0.15915494309189535; rev -= rint(rev);
              const float fr = (float)rev;
              rope[e] = make_float2(__builtin_amdgcn_cosf(fr), __builtin_amdgcn_sinf(fr)); } }
        if (gt == 0) { const float* lf = INP(18); float a = 0.f, b = 0.f;
            for (int i = 0; i < 64; ++i) { a += lf[i] * lf[64 + i]; b += lf[128 + i] * lf[192 + i]; }
            const float lambda_init = 0.8f - 0.6f * expf(-0.3f);
            *(float*)(ws + S_LAM) = expf(a) - expf(b) + lambda_init; }
    }
    SEAM(0);
    REP(1) if (IN(1)) {
        run_gemm(lds, XN, (const bf16*)(ws + W_WIN), T, ZW, 1024, pg8::EpiStore{(bf16*)(ws + A_Z), ZW}, bid);
        run_gemm(lds, (const bf16*)(ws + S_MN), (const bf16*)(ws + W_WMKV), 512, 1024, 1024, pg8::EpiStore{(bf16*)(ws + S_MKV), 1024}, (bid + 128) % G);
        run_gemm(lds, (const bf16*)(ws + S_MN) + (size_t)512 * 1024, (const bf16*)(ws + W_WMKV) + (size_t)1024 * 1024, 512, 1024, 1024, pg8::EpiStore{(bf16*)(ws + S_MKV) + (size_t)512 * 1024, 1024}, (bid + 192) % G);
    }
    SEAM(1);
    REP(2) if (IN(2)) {
        PHASE_IDS;
        const bf16* Z = (const bf16*)(ws + A_Z);
        for (int it = gw; it < 2 * T; it += NGW) {
            const int row = it >> 1; const bf16* zr = Z + (size_t)row * ZW;
            if ((it & 1) == 0) {
                const u32x4 v = *(const u32x4*)(zr + lane * 8);
                float ss = chunk_ss(v); ss += shfl_xor_l(ss, 1, lane); ss += shfl_xor_l(ss, 2, lane); ss += shfl_xor_l(ss, 4, lane);
                const float r = (1.0f / sqrtf(ss * (1.f / 64.f) + EPS)) * (0.125f * LOG2E);
                *(u32x4*)((bf16*)(ws + A_QA) + (size_t)row * 512 + lane * 8) = chunk_scale(v, r, INP(5) + (lane & 7) * 8);
            } else {
                const int seg = lane < 16 ? 0 : (lane < 32 ? 1 : 2);
                const int col = seg == 0 ? 512 + lane * 8 : (seg == 1 ? 1024 + (lane - 16) * 8 : 768 + (lane - 32) * 8);
                const u32x4 v = *(const u32x4*)(zr + col);
                float ss = chunk_ss(v); ss += shfl_xor_l(ss, 1, lane); ss += shfl_xor_l(ss, 2, lane); ss += shfl_xor_l(ss, 4, lane);
                { const float t8 = shfl_xor_l(ss, 8, lane); if (seg >= 1) ss += t8; }
                { const float t16 = shfl_xor_l(ss, 16, lane); if (seg == 2) ss += t16; }
                const float n = seg == 0 ? 64.f : (seg == 1 ? 128.f : 256.f);
                const float r = 1.0f / sqrtf(ss / n + EPS);
                const float* g = seg == 0 ? INP(6) + (lane & 7) * 8 : (seg == 1 ? INP(9) + (lane - 16) * 8 : INP(8) + (lane - 32) * 8);
                bf16* d = seg == 0 ? (bf16*)(ws + A_KA) + (size_t)row * 128 + lane * 8 : (seg == 1 ? (bf16*)(ws + A_CKVN) + (size_t)row * 128 + (lane - 16) * 8 : (bf16*)(ws + A_CQN) + (size_t)row * 256 + (lane - 32) * 8);
                *(u32x4*)d = chunk_scale(v, r, g);
            }
        }
        for (int j = gt; j < 2 * 512 * 4; j += NGT) { const int ly = j >> 11, row = (j >> 2) & 511, h = j & 3;
            rms_group<128>((const bf16*)(ws + S_MKV) + ((size_t)ly * 512 + row) * 1024 + h * 128, (bf16*)(ws + S_MK) + ((size_t)ly * 512 + row) * 512 + h * 128, INP(26) + ly * 128, 1.0f); }
        transpose_tiles<2>(lds, Z, ZW, 640, 64, 2, (bf16*)(ws + A_VTA), 128, SEQ, T, bid, G, tid);
        for (int ly = 0; ly < 2; ++ly)
            transpose_tiles<4>(lds, (const bf16*)(ws + S_MKV) + (size_t)ly * 512 * 1024, 1024, 512, 64, 8, (bf16*)(ws + S_VTM) + (size_t)ly * 2 * 512 * 256, 512, MEMT, 512, bid, G, tid);
    }
    SEAM(2);
    REP(3) if (IN(3)) {
#ifndef NO_P3
        run_gemm(lds, (const bf16*)(ws + A_CQN), (const bf16*)(ws + W_WUQ), T, 768, 256, pg8::EpiStore{(bf16*)(ws + A_QF), 768}, bid);
        run_gemm(lds, (const bf16*)(ws + A_CKVN), (const bf16*)(ws + W_WUKV), T, 1024, 128, pg8::EpiStore{(bf16*)(ws + A_KV), 1024}, bid);
#endif
    }
    SEAM(3);
    REP(4) if (IN(4)) {
        PHASE_IDS;
        const bf16* Z = (const bf16*)(ws + A_Z); const bf16* QF = (const bf16*)(ws + A_QF); const bf16* KV = (const bf16*)(ws + A_KV);
        const float2* rope = (const float2*)(ws + S_ROPE);
        const float qsc = 0.10206207261596577f * LOG2E;
        for (int it = gw; it < 2 * T * 2; it += NGW) {
            const int which = it >= T * 2, j = which ? it - T * 2 : it, row = j >> 1, h = (j & 1) * 4 + (lane >> 4), sub = lane & 15;
            const bool act = sub < 12;
            const bf16* src = !which ? QF + (size_t)row * 768 + h * 96 + sub * 8 : (sub < 8 ? KV + (size_t)row * 1024 + h * 128 + sub * 8 : Z + (size_t)row * ZW + 1152 + (sub - 8) * 8);
            const u32x4 zero4 = {0u, 0u, 0u, 0u};
            const u32x4 v = act ? *(const u32x4*)src : zero4;
            float ss = chunk_ss(v); ss += shfl_xor_l(ss, 1, lane); ss += shfl_xor_l(ss, 2, lane); ss += shfl_xor_l(ss, 4, lane); ss += shfl_xor_l(ss, 8, lane);
            const float r = (1.0f / sqrtf(ss * (1.f / 96.f) + EPS)) * (which ? 1.0f : qsc);
            const float* gain = which ? INP(13) : INP(12);
            u32x4 pv;
            pv.x = __builtin_amdgcn_ds_bpermute((lane ^ 2) << 2, v.x); pv.y = __builtin_amdgcn_ds_bpermute((lane ^ 2) << 2, v.y);
            pv.z = __builtin_amdgcn_ds_bpermute((lane ^ 2) << 2, v.z); pv.w = __builtin_amdgcn_ds_bpermute((lane ^ 2) << 2, v.w);
            if (act) {
                bf16* dst = (bf16*)(ws + (which ? A_KB : A_QB)) + (size_t)row * 768 + h * 96 + sub * 8;
                float f[8]; UNPK8(v, f);
                const float* g = gain + sub * 8;
#pragma unroll
                for (int i = 0; i < 8; ++i) f[i] *= r * g[i];
                if (sub >= 8) {
                    float pf_[8]; UNPK8(pv, pf_);
                    const float* gp = gain + (sub ^ 2) * 8; const float2* cs = rope + (size_t)row * 16 + (sub & 1) * 8;
#pragma unroll
                    for (int i = 0; i < 8; ++i) { const float pn = pf_[i] * r * gp[i]; const float2 c = cs[i];
                        f[i] = (sub < 10) ? (f[i] * c.x - pn * c.y) : (f[i] * c.x + pn * c.y); }
                }
                u32x4 o; PACK8(o, f); *(u32x4*)dst = o;
            }
        }
        transpose_tiles<4>(lds, KV, 1024, 64, 128, 8, (bf16*)(ws + A_VTB), 512, SEQ, T, bid, G, tid);
    }
    SEAM(4);
    REP(5) if (IN(5)) {
        bf16* ATT = (bf16*)(ws + A_ATT);
        for (int j = bid; j < 1024; j += G) {
            int combo, qb; causal_slot(j, 16, combo, qb);
            const int b = combo >> 3, h = combo & 7; const size_t row0 = (size_t)b * SEQ + qb * 256;
#ifndef NO_MLA
            attn_unit<96, 64, AF_CAUSAL, 768, 768, SEQ, 1024>(lds, (const bf16*)(ws + A_QB) + row0 * 768 + h * 96, (const bf16*)(ws + A_KB) + (size_t)b * SEQ * 768 + h * 96,
                                         (const bf16*)(ws + A_VTB) + ((size_t)b * 512 + h * 64) * SEQ, ATT + row0 * 1024 + 512 + h * 64, qb * 256, 0, 4 * (qb + 1), 0.f, 0.f, nullptr, 0.f);
#endif
        }
        for (int j = bid; j < 1024; j += G) {
            const int b = j >> 9, h = (j >> 6) & 7, qb = j & 63, hk = h >> 2; const size_t row0 = (size_t)b * SEQ + qb * 256;
            const int q0 = qb * 256, klo = (q0 >= 128) ? (q0 - 128) / 64 : 0;
#ifndef NO_SWA
            attn_unit<64, 64, AF_CAUSAL | AF_WINDOW | AF_ALIBI | AF_SINK | AF_ROBUST, 512, 128, SEQ, 1024>(lds, (const bf16*)(ws + A_QA) + row0 * 512 + h * 64, (const bf16*)(ws + A_KA) + (size_t)b * SEQ * 128 + hk * 64,
                                         (const bf16*)(ws + A_VTA) + ((size_t)b * 128 + hk * 64) * SEQ, ATT + row0 * 1024 + h * 64, q0, klo, 4 * (qb + 1),
                                         exp2f(-(float)(h + 1)) * LOG2E, INP(7)[h] * LOG2E, nullptr, 0.f);
#endif
        }
    }
    SEAM(5);
    REP(6) if (IN(6)) run_gemm(lds, (const bf16*)(ws + A_ATT), (const bf16*)(ws + W_WO0), T, 1024, 1024, pg8::EpiResX<true, false>{x, XH, 1024}, bid);
    SEAM(6);
#pragma unroll 1
    for (int ly = 0; ly < 2; ++ly) {
        const int pb = ly ? 20 : 7;
        if (ly == 1) {
            if (IN(14)) { PHASE_IDS; norm_phase_h(XH, INP(3) + DM, XN, gw, NGW, lane); }
            SEAM(14);
            REP(15) if (IN(15)) run_gemm(lds, XN, (const bf16*)(ws + W_WQKV), T, 3072, 1024, pg8::EpiQKV{QDb, KDb, (bf16*)(ws + A_QKV), INP(16), INP(17), 0.125f * LOG2E}, bid);
            SEAM(15);
            REP(16) if (IN(16)) {
                PHASE_IDS;
                const bf16* QKV = (const bf16*)(ws + A_QKV);
                transpose_tiles<4>(lds, QKV, 3072, 2048, 64, 16, (bf16*)(ws + A_VTD), 1024, SEQ, T, bid, G, tid);
            }
            SEAM(16);
            REP(17) if (IN(17)) {
                float gq = 0.f, gk = 0.f;
                { const float* g1 = INP(16); const float* g2 = INP(17);
                  for (int i = 0; i < 64; ++i) { gq = fmaxf(gq, fabsf(g1[i])); gk = fmaxf(gk, fabsf(g2[i])); } }
                const float Bq = 8.0f * gq * gk * LOG2E * 1.05f;
                unsigned* qctr = (unsigned*)(ws + S_CTL) + 3600;
                volatile LAS unsigned* qslot = (volatile LAS unsigned*)(lds + LDS_ST_OFF + 8);
                for (;;) {
                    if (threadIdx.x == 0) *qslot = __hip_atomic_fetch_add(qctr, 1u, __ATOMIC_RELAXED, __HIP_MEMORY_SCOPE_AGENT);
                    __syncthreads();
                    const int j = (int)*qslot;
                    __syncthreads();
                    if (j >= 2048) break;
                    const int qb = 63 - (j >> 5), c = j & 31, h = 7 - (c >> 2), b = (c >> 1) & 1, st = c & 1; const size_t row0 = (size_t)b * SEQ + qb * 256;
                    const float slope2 = exp2f(-(float)(h + 1)) * LOG2E;
                    const int q0 = qb * 256, cutkeys = (int)((2.0f * Bq + 160.0f) / slope2) + 1;
                    const int klo = (q0 - 63 - cutkeys >= 0) ? (q0 - 63 - cutkeys) / 64 + 1 : 0;
#ifndef NO_DIFF
                    attn_unit<64, 128, AF_CAUSAL | AF_ALIBI | AF_REV, 1024, 1024, SEQ, 1024>(lds, QDb + row0 * 1024 + (2 * h + st) * 64, KDb + (size_t)b * SEQ * 1024 + (2 * h + st) * 64,
                                         (const bf16*)(ws + A_VTD) + ((size_t)b * 1024 + h * 128) * SEQ, (bf16*)(ws + (st ? A_O2 : A_O1)) + row0 * 1024 + h * 128, q0, klo, 4 * (qb + 1),
                                         slope2, 0.f, nullptr, 0.f);
#endif
                }
            }
            SEAM(17);
            REP(18) if (IN(18)) {
                PHASE_IDS;
                const float lam = *(const float*)(ws + S_LAM); const float osc = 1.0f - (0.8f - 0.6f * expf(-0.3f));
                const float* gsub = INP(19);
                for (int it = gw; it < T * 2; it += NGW) {
                    const size_t off = (size_t)it * 512 + lane * 8;
                    const u32x4 v1 = *(const u32x4*)((const bf16*)(ws + A_O1) + off), v2 = *(const u32x4*)((const bf16*)(ws + A_O2) + off);
                    float a[8], b2[8]; UNPK8(v1, a); UNPK8(v2, b2);
                    float ss = 0.f;
#pragma unroll
                    for (int i = 0; i < 8; ++i) { a[i] -= lam * b2[i]; ss += a[i] * a[i]; }
                    ss += shfl_xor_l(ss, 1, lane); ss += shfl_xor_l(ss, 2, lane); ss += shfl_xor_l(ss, 4, lane); ss += shfl_xor_l(ss, 8, lane);
                    const float r = (1.0f / sqrtf(ss * (1.f / 128.f) + EPS)) * osc;
                    const float* g = gsub + (lane & 15) * 8;
#pragma unroll
                    for (int i = 0; i < 8; ++i) a[i] *= r * g[i];
                    u32x4 w; PACK8(w, a); *(u32x4*)((bf16*)(ws + A_DO) + off) = w;
                }
            }
            SEAM(18);
            if (IN(19)) run_gemm(lds, (const bf16*)(ws + A_DO), (const bf16*)(ws + W_WDO), T, 1024, 1024, pg8::EpiResX<false, false>{XH, XH, 1024}, bid);
            SEAM(19);
        }
        REP(pb + 0) if (IN(pb + 0)) { PHASE_IDS; norm_phase_h(XH, INP(21) + ly * DM, XN, gw, NGW, lane); }
        SEAM(pb + 0);
        REP(pb + 1) if (IN(pb + 1)) run_gemm(lds, XN, (const bf16*)(ws + W_WMQ) + (size_t)ly * 512 * 1024, T, 512, 1024, pg8::EpiStore{(bf16*)(ws + A_QM), 512}, bid);
        SEAM(pb + 1);
        REP(pb + 2) if (IN(pb + 2)) {
            for (int j = bid; j < 512; j += G) {
                const int b = j >> 8, h = (j >> 6) & 3, qb = j & 63; const size_t row0 = (size_t)b * SEQ + qb * 256;
#ifndef NO_MEM
                attn_unit<128, 128, AF_QNORM, 512, 512, MEMT, 512>(lds, (const bf16*)(ws + A_QM) + row0 * 512 + h * 128, (const bf16*)(ws + S_MK) + ((size_t)ly * 512 + b * 256) * 512 + h * 128,
                                         (const bf16*)(ws + S_VTM) + (((size_t)ly * 2 + b) * 512 + h * 128) * 256, (bf16*)(ws + A_MO) + row0 * 512 + h * 128, 0, 0, 4,
                                         0.f, 0.f, INP(25) + ly * 128, 0.08838834764831845f * LOG2E);
#endif
            }
        }
        SEAM(pb + 2);
        if (IN(pb + 3)) run_gemm(lds, (const bf16*)(ws + A_MO), (const bf16*)(ws + W_WMO) + (size_t)ly * 1024 * 512, T, 1024, 512, pg8::EpiResX<false, false>{XH, XH, 1024}, bid);
        SEAM(pb + 3);
        if (IN(pb + 4)) { PHASE_IDS; norm_phase_h(XH, INP(28) + ly * DM, XN, gw, NGW, lane); }
        SEAM(pb + 4);
        REP(pb + 5) if (IN(pb + 5)) run_gemm(lds, XN, (const bf16*)(ws + W_WGU) + (size_t)ly * 5632 * 1024, T, 5632, 1024, pg8::EpiSwiglu{(bf16*)(ws + A_H), DFF}, bid);
        SEAM(pb + 5);
        if (IN(pb + 6)) { if (ly == 0) run_gemm(lds, (const bf16*)(ws + A_H), (const bf16*)(ws + W_WD), T, 1024, DFF, pg8::EpiResX<false, false>{XH, XH, 1024}, bid);
                          else run_gemm(lds, (const bf16*)(ws + A_H), (const bf16*)(ws + W_WD) + (size_t)1024 * DFF, T, 1024, DFF, pg8::EpiResX<false, true>{XH, args.out, 1024}, bid); }
        if (ly == 0) SEAM(13);
    }
#undef IN
#undef REP
#undef SEAM
#undef G
#undef bid
#undef NGW
#undef NGT
#undef PHASE_IDS
}

#undef INP
extern "C" void kernel_launch(void* const* d_in, const int* in_sizes, int n_in, void* d_out, int out_size, void* d_ws, size_t ws_size, hipStream_t stream) {
    static int grid = 0;
    if (grid == 0) {
        if (n_in != 32 || out_size != T * DM || ws_size < WS_NEED) { fprintf(stderr, "kernel_launch: unexpected shapes (n_in %d out %d ws %zu)\n", n_in, out_size, ws_size); grid = -1; return; }
        int dev = 0, cus = 0, per_cu = 0;
        hipGetDevice(&dev); hipDeviceGetAttribute(&cus, hipDeviceAttributeMultiprocessorCount, dev);
        if (hipFuncSetAttribute((const void*)mega_fwd, hipFuncAttributeMaxDynamicSharedMemorySize, LDS_BYTES) != hipSuccess) { fprintf(stderr, "kernel_launch: hipFuncSetAttribute failed\n"); grid = -1; return; }
        if (hipOccupancyMaxActiveBlocksPerMultiprocessor(&per_cu, (const void*)mega_fwd, NTHREADS, LDS_BYTES) != hipSuccess || per_cu < 1) { fprintf(stderr, "kernel_launch: occupancy query says %d\n", per_cu); per_cu = 1; }
        (void)hipGetLastError();
        grid = cus * 1;
        (void)per_cu;
    }
    if (grid < 0) return;
    Args a{};
    for (int i = 0; i < 32; ++i) a.in[i] = (const float*)d_in[i];
    a.out = (float*)d_out; a.ws = (unsigned char*)d_ws;
#if MK_MULTI
    for (int ph = 0; ph < NPHASE; ++ph) { a.ph_lo = ph; a.ph_hi = ph + 1; hipLaunchKernelGGL(mega_fwd, dim3(grid), dim3(NTHREADS), LDS_BYTES, stream, a); }
#else
    a.ph_lo = 0; a.ph_hi = NPHASE;
    if (hipMemsetAsync((char*)d_ws + S_CTL, 0, 16384, stream) != hipSuccess) { fprintf(stderr, "kernel_launch: memset failed\n"); return; }
    void* kargs[] = {&a};
    hipError_t e = hipLaunchCooperativeKernel((const void*)mega_fwd, dim3(grid), dim3(NTHREADS), kargs, LDS_BYTES, stream);
    if (e != hipSuccess) fprintf(stderr, "cooperative launch failed: %s (grid %d)\n", hipGetErrorString(e), grid);
#endif
}
```

```cpp
#include <hip/hip_runtime.h>
#include <hip/hip_cooperative_groups.h>
#include <cstdio>
#include <cstdint>
namespace cg = cooperative_groups;
#ifndef MK_MULTI
#define MK_MULTI 0
#endif
namespace pg8 {
#define PG8_LAS __attribute__((address_space(3)))
typedef unsigned short bf16_t;
typedef short bf16x8 __attribute__((ext_vector_type(8)));
typedef float f32x4 __attribute__((ext_vector_type(4)));
typedef unsigned u32x4 __attribute__((ext_vector_type(4)));
constexpr int BM = 256, BK = 64, HALF = 128, HTB = HALF * BK * 2  , STAGE_BYTES = 8 * HTB, NXCD = 8, WGM = 8;

__host__ __device__ __forceinline__ int lds_byte(int r, int c) { const int st = (r >> 4) * 2 + (c >> 5), rr = r & 15, cc = c & 31, ob = rr * 64 + cc * 2; return st * 1024 + (ob ^ (((ob >> 9) & 1) << 5)); }
__host__ __device__ __forceinline__ void stage_rc(int b, int& R, int& C) { const int st = b / 1024, sb = b % 1024, swz = sb ^ (((sb >> 9) & 1) << 5); R = (st >> 1) * 16 + swz / 64; C = (st & 1) * 32 + (swz % 64) / 2; }
__host__ __device__ __forceinline__ int perm32(int rho) { const int n = rho >> 4, i = rho & 15; return 8 * (i >> 2) + 4 * n + (i & 3); }

struct Unit { int pm, pn; };
struct Gemm { const bf16_t* A; const bf16_t* Bt; int M, N, K; };

struct StaticOrder {
    int nM, nN, nwg, G, c;
    __host__ __device__ void init(int M, int N, int G_, int c_) { nM = M / BM; nN = N / BM; nwg = nM * nN; G = G_; c = c_; }
    __host__ __device__ bool next(int i, Unit& u) const {
        const long L = (long)i * G + c; if (L >= nwg) return false;
        int wgid = (int)L; { const int q = nwg / NXCD, r = nwg % NXCD, xcd = wgid % NXCD, off = wgid / NXCD; wgid = (xcd < r ? xcd * (q + 1) : r * (q + 1) + (xcd - r) * q) + off; }
        const int nig = WGM * nN, gid = wgid / nig, fm = gid * WGM, gsz = (nM - fm) < WGM ? (nM - fm) : WGM;
        u.pm = fm + ((wgid % nig) % gsz); u.pn = (wgid % nig) / gsz; return true;
    }
    __device__ __forceinline__ void a_ready(const Unit&) const {}
    __device__ __forceinline__ void done(const Unit&) const {}
};

__device__ __forceinline__ unsigned cvt_pk_bf16(float lo, float hi) { unsigned r; asm volatile("v_cvt_pk_bf16_f32 %0, %1, %2" : "=v"(r) : "v"(lo), "v"(hi)); return r; }
struct EpiStore {
    static constexpr bool PERM = true, AFTER_DRAIN = false;
    bf16_t* O; int ldc;
    __device__ __forceinline__ void operator()(const f32x4 (&acc)[2][2][4][2], const Unit& u, int wr, int wc, int fr, int fq) const {
        const int row0 = u.pm * BM + wr * 64 + fr, col0 = u.pn * BM + wc * 32 + 8 * fq;
#pragma unroll
        for (int ai = 0; ai < 2; ++ai)
#pragma unroll
            for (int m = 0; m < 4; ++m) { bf16_t* rowp = O + (size_t)(row0 + ai * HALF + m * 16) * ldc + col0;
#pragma unroll
                for (int bj = 0; bj < 2; ++bj) { const f32x4 v0 = acc[ai][bj][m][0], v1 = acc[ai][bj][m][1];
                    u32x4 w; w.x = cvt_pk_bf16(v0[0], v0[1]); w.y = cvt_pk_bf16(v0[2], v0[3]); w.z = cvt_pk_bf16(v1[0], v1[1]); w.w = cvt_pk_bf16(v1[2], v1[3]);
                    *(u32x4*)(rowp + bj * HALF) = w; } }
    }
};
struct EpiResid {
    static constexpr bool PERM = true, AFTER_DRAIN = false;
    const float* R; float* O; int ld;
    __device__ __forceinline__ void operator()(const f32x4 (&acc)[2][2][4][2], const Unit& u, int wr, int wc, int fr, int fq) const {
        const int row0 = u.pm * BM + wr * 64 + fr, col0 = u.pn * BM + wc * 32 + 8 * fq;
#pragma unroll
        for (int ai = 0; ai < 2; ++ai)
#pragma unroll
            for (int m = 0; m < 4; ++m) { const size_t off = (size_t)(row0 + ai * HALF + m * 16) * ld + col0; __builtin_amdgcn_sched_barrier(0);
#pragma unroll
                for (int bj = 0; bj < 2; ++bj) {
                    const f32x4 r0 = *(const f32x4*)(R + off + bj * HALF), r1 = *(const f32x4*)(R + off + bj * HALF + 4);
                    *(f32x4*)(O + off + bj * HALF) = r0 + acc[ai][bj][m][0]; *(f32x4*)(O + off + bj * HALF + 4) = r1 + acc[ai][bj][m][1]; } }
    }
};
template <bool RF32, bool OF32> struct EpiResX {
    static constexpr bool PERM = true, AFTER_DRAIN = false;
    const void* R; void* O; int ld;
    __device__ __forceinline__ void operator()(const f32x4 (&acc)[2][2][4][2], const Unit& u, int wr, int wc, int fr, int fq) const {
        const int row0 = u.pm * BM + wr * 64 + fr, col0 = u.pn * BM + wc * 32 + 8 * fq;
#pragma unroll
        for (int ai = 0; ai < 2; ++ai)
#pragma unroll
            for (int m = 0; m < 4; ++m) { const size_t off = (size_t)(row0 + ai * HALF + m * 16) * ld + col0; __builtin_amdgcn_sched_barrier(0);
#pragma unroll
                for (int bj = 0; bj < 2; ++bj) {
                    f32x4 r0, r1;
                    if (RF32) { r0 = *(const f32x4*)((const float*)R + off + bj * HALF); r1 = *(const f32x4*)((const float*)R + off + bj * HALF + 4); }
                    else { const u32x4 w = *(const u32x4*)((const bf16_t*)R + off + bj * HALF);
                        r0 = (f32x4){__builtin_bit_cast(float, w.x << 16), __builtin_bit_cast(float, w.x & 0xffff0000u), __builtin_bit_cast(float, w.y << 16), __builtin_bit_cast(float, w.y & 0xffff0000u)};
                        r1 = (f32x4){__builtin_bit_cast(float, w.z << 16), __builtin_bit_cast(float, w.z & 0xffff0000u), __builtin_bit_cast(float, w.w << 16), __builtin_bit_cast(float, w.w & 0xffff0000u)}; }
                    const f32x4 n0 = r0 + acc[ai][bj][m][0], n1 = r1 + acc[ai][bj][m][1];
                    if (OF32) { *(f32x4*)((float*)O + off + bj * HALF) = n0; *(f32x4*)((float*)O + off + bj * HALF + 4) = n1; }
                    else { u32x4 w; w.x = cvt_pk_bf16(n0[0], n0[1]); w.y = cvt_pk_bf16(n0[2], n0[3]); w.z = cvt_pk_bf16(n1[0], n1[1]); w.w = cvt_pk_bf16(n1[2], n1[3]);
                        *(u32x4*)((bf16_t*)O + off + bj * HALF) = w; } } }
    }
};
struct EpiQKV {
    static constexpr bool PERM = true, AFTER_DRAIN = false;
    bf16_t* QD; bf16_t* KD; bf16_t* V; const float* gq; const float* gk; float qscale;
    __device__ __forceinline__ void operator()(const f32x4 (&acc)[2][2][4][2], const Unit& u, int wr, int wc, int fr, int fq) const {
        const int row0 = u.pm * BM + wr * 64 + fr;
        if (u.pn >= 8) {
            const int col0 = u.pn * BM + wc * 32 + 8 * fq;
#pragma unroll
            for (int ai = 0; ai < 2; ++ai)
#pragma unroll
                for (int m = 0; m < 4; ++m) { bf16_t* rowp = V + (size_t)(row0 + ai * HALF + m * 16) * 3072 + col0;
#pragma unroll
                    for (int bj = 0; bj < 2; ++bj) { const f32x4 v0 = acc[ai][bj][m][0], v1 = acc[ai][bj][m][1];
                        u32x4 w; w.x = cvt_pk_bf16(v0[0], v0[1]); w.y = cvt_pk_bf16(v0[2], v0[3]); w.z = cvt_pk_bf16(v1[0], v1[1]); w.w = cvt_pk_bf16(v1[2], v1[3]);
                        *(u32x4*)(rowp + bj * HALF) = w; } }
        } else {
            const bool isk = u.pn >= 4; bf16_t* D = isk ? KD : QD; const float* g = (isk ? gk : gq) + 8 * fq; const float sc = isk ? 1.0f : qscale;
            const int lc0 = (u.pn & 3) * 256 + 64 * wc + 8 * fq;
            const f32x4 ga0 = *(const f32x4*)g, ga1 = *(const f32x4*)(g + 4), gb0 = *(const f32x4*)(g + 32), gb1 = *(const f32x4*)(g + 36);
#pragma unroll
            for (int ai = 0; ai < 2; ++ai)
#pragma unroll
                for (int m = 0; m < 4; ++m) { __builtin_amdgcn_sched_barrier(0);
                    const f32x4 a0 = acc[ai][0][m][0], a1 = acc[ai][0][m][1], b0 = acc[ai][1][m][0], b1 = acc[ai][1][m][1];
                    float ss = ((a0[0] * a0[0] + a0[1] * a0[1]) + (a0[2] * a0[2] + a0[3] * a0[3])) + ((a1[0] * a1[0] + a1[1] * a1[1]) + (a1[2] * a1[2] + a1[3] * a1[3]))
                             + ((b0[0] * b0[0] + b0[1] * b0[1]) + (b0[2] * b0[2] + b0[3] * b0[3])) + ((b1[0] * b1[0] + b1[1] * b1[1]) + (b1[2] * b1[2] + b1[3] * b1[3]));
                    ss += __shfl_xor(ss, 16); ss += __shfl_xor(ss, 32);
                    const float r = sc / __builtin_sqrtf(ss * (1.0f / 64.0f) + 1e-6f);
                    const f32x4 x0 = a0 * ga0 * r, x1 = a1 * ga1 * r, y0 = b0 * gb0 * r, y1 = b1 * gb1 * r;
                    bf16_t* rowp = D + (size_t)(row0 + ai * HALF + m * 16) * 1024 + lc0;
                    u32x4 w; w.x = cvt_pk_bf16(x0[0], x0[1]); w.y = cvt_pk_bf16(x0[2], x0[3]); w.z = cvt_pk_bf16(x1[0], x1[1]); w.w = cvt_pk_bf16(x1[2], x1[3]);
                    *(u32x4*)rowp = w;
                    w.x = cvt_pk_bf16(y0[0], y0[1]); w.y = cvt_pk_bf16(y0[2], y0[3]); w.z = cvt_pk_bf16(y1[0], y1[1]); w.w = cvt_pk_bf16(y1[2], y1[3]);
                    *(u32x4*)(rowp + 32) = w; }
        }
    }
};
struct EpiSwiglu {
    static constexpr bool PERM = true, AFTER_DRAIN = false;
    bf16_t* O; int ldc;
    __device__ __forceinline__ void operator()(const f32x4 (&acc)[2][2][4][2], const Unit& u, int wr, int wc, int fr, int fq) const {
        const int row0 = u.pm * BM + wr * 64 + fr, col0 = u.pn * HALF + wc * 32 + 8 * fq;
#pragma unroll
        for (int ai = 0; ai < 2; ++ai)
#pragma unroll
            for (int m = 0; m < 4; ++m) { bf16_t* rowp = O + (size_t)(row0 + ai * HALF + m * 16) * ldc + col0;
                float h[8]; __builtin_amdgcn_sched_barrier(0);
#pragma unroll
                for (int n = 0; n < 2; ++n)
#pragma unroll
                    for (int i = 0; i < 4; ++i) { const float g = acc[ai][0][m][n][i], up = acc[ai][1][m][n][i];
                        h[4 * n + i] = g * __builtin_amdgcn_rcpf(1.0f + __builtin_amdgcn_exp2f(-1.4426950408889634f * g)) * up; }
                u32x4 w; w.x = cvt_pk_bf16(h[0], h[1]); w.y = cvt_pk_bf16(h[2], h[3]); w.z = cvt_pk_bf16(h[4], h[5]); w.w = cvt_pk_bf16(h[6], h[7]);
                *(u32x4*)rowp = w; }
    }
};
template <class Epi, class Sched, bool ALIGN_EPI = false, bool SP2 = false>
__device__ __forceinline__ void gemm_phase(PG8_LAS unsigned char* lds, const Gemm g, const Sched& S, const Epi& E) {
    int tid_o = threadIdx.x; asm volatile("" : "+v"(tid_o)); const int tid = tid_o, wid = __builtin_amdgcn_readfirstlane(tid >> 6), lane = tid & 63, wr = wid >> 2, wc = wid & 3, fr = lane & 15, fq = lane >> 4;
    const int K = g.K, nt = K / BK;
    unsigned voffA[2], voffB[2];
#pragma unroll
    for (int i = 0; i < 2; ++i) { int R, C; stage_rc(tid * 16 + i * 8192, R, C); const int Rb = Epi::PERM ? ((R & ~31) + perm32(R & 31)) : R;
        voffA[i] = (unsigned)(R * K + C) * 2u; voffB[i] = (unsigned)(Rb * K + C) * 2u; }
    const size_t kstep = (size_t)(BK * 2);
    const size_t hstep = (size_t)HALF * K * 2;
    const size_t tstep = 2 * hstep;
    const unsigned ldsw = (unsigned)wid * 1024u;
    const int aoff = lds_byte(wr * 64 + fr, fq * 8), boff = lds_byte(wc * 32 + fr, fq * 8);
#define PG8_SA(b, h) (((b) * 2 + (h)) * HTB)
#define PG8_SB(b, h) ((4 + (b) * 2 + (h)) * HTB)
#define PG8_STAGE(bufoff, gbase, voff) do { _Pragma("unroll") for (int _i = 0; _i < 2; ++_i) \
        __builtin_amdgcn_global_load_lds((const unsigned*)((const char*)(gbase) + (voff)[_i]), (PG8_LAS unsigned*)(lds + (bufoff) + ldsw + _i * 8192), 16, 0, 0); } while (0)
#define PG8_LDA(dst, b, h) do { _Pragma("unroll") for (int m = 0; m < 4; ++m) _Pragma("unroll") for (int k = 0; k < 2; ++k) dst[m][k] = *(const PG8_LAS bf16x8*)(lds + PG8_SA(b, h) + aoff + m * 2048 + k * 1024); } while (0)
#define PG8_LDB(dst, b, h) do { _Pragma("unroll") for (int n = 0; n < 2; ++n) _Pragma("unroll") for (int k = 0; k < 2; ++k) dst[n][k] = *(const PG8_LAS bf16x8*)(lds + PG8_SB(b, h) + boff + n * 2048 + k * 1024); } while (0)
#define PG8_MMA(ai, bj, At, Bt) do { __builtin_amdgcn_s_setprio(1); _Pragma("unroll") for (int m = 0; m < 4; ++m) _Pragma("unroll") for (int n = 0; n < 2; ++n) _Pragma("unroll") for (int k = 0; k < 2; ++k) \
        acc[ai][bj][m][n] = __builtin_amdgcn_mfma_f32_16x16x32_bf16(Bt[n][k], At[m][k], acc[ai][bj][m][n], 0, 0, 0); __builtin_amdgcn_s_setprio(0); } while (0)
#define PG8_WAIT_V(n) asm volatile("s_waitcnt vmcnt(" #n ")" ::: "memory")
#define PG8_WAIT_L(n) asm volatile("s_waitcnt lgkmcnt(" #n ")" ::: "memory")
#define PG8_BAR __builtin_amdgcn_s_barrier()
#define PG8_SCHED __builtin_amdgcn_sched_barrier(0)
    Unit cur, nxt; int ui = 0;
    if (!S.next(0, cur)) return;
    f32x4 acc[2][2][4][2];
#pragma unroll
    for (int a = 0; a < 2; ++a)
#pragma unroll
        for (int b = 0; b < 2; ++b)
#pragma unroll
            for (int m = 0; m < 4; ++m)
#pragma unroll
                for (int n = 0; n < 2; ++n) acc[a][b][m][n] = (f32x4){0.f, 0.f, 0.f, 0.f};
    bf16x8 At[4][2], B0[2][2], B1[2][2];
    const char* cA = (const char*)g.A + (size_t)cur.pm * tstep; const char* cB = (const char*)g.Bt + (size_t)cur.pn * tstep;
    S.a_ready(cur);
    if constexpr (SP2) {
        PG8_STAGE(PG8_SB(0, 0), cB, voffB); PG8_STAGE(PG8_SB(0, 1), cB + hstep, voffB); PG8_STAGE(PG8_SA(0, 0), cA, voffA); PG8_STAGE(PG8_SA(0, 1), cA + hstep, voffA);
        if (wr == 1) PG8_BAR;
        PG8_WAIT_V(2); PG8_BAR;
        PG8_STAGE(PG8_SB(1, 0), cB + kstep, voffB); PG8_STAGE(PG8_SA(1, 0), cA + kstep, voffA); PG8_STAGE(PG8_SB(1, 1), cB + hstep + kstep, voffB);
        PG8_WAIT_V(6); PG8_BAR;
    } else {
        PG8_STAGE(PG8_SB(0, 0), cB, voffB); PG8_STAGE(PG8_SA(0, 0), cA, voffA); PG8_STAGE(PG8_SB(0, 1), cB + hstep, voffB); PG8_STAGE(PG8_SA(0, 1), cA + hstep, voffA);
        if (wr == 1) PG8_BAR;
        PG8_WAIT_V(4); PG8_BAR;
        PG8_STAGE(PG8_SB(1, 0), cB + kstep, voffB); PG8_STAGE(PG8_SA(1, 0), cA + kstep, voffA); PG8_STAGE(PG8_SB(1, 1), cB + hstep + kstep, voffB);
        PG8_WAIT_V(6); PG8_BAR;
    }
    for (;;) {
        const bool has_next = S.next(ui + 1, nxt);
        const char* nA = has_next ? (const char*)g.A + (size_t)nxt.pm * tstep : cA; const char* nB = has_next ? (const char*)g.Bt + (size_t)nxt.pn * tstep : cB;
        for (int t = 0; t < nt; t += 2) {
            const bool last = (t == nt - 2);
            const char* a1 = cA + (size_t)(t + 1) * kstep;
            const char* a2 = last ? nA : cA + (size_t)(t + 2) * kstep; const char* b2 = last ? nB : cB + (size_t)(t + 2) * kstep;
            const char* a3 = a2 + kstep; const char* b3 = b2 + kstep;
            if (last && has_next) S.a_ready(nxt);
            if constexpr (SP2) {
            PG8_LDB(B0, 0, 0); PG8_LDB(B1, 0, 1); PG8_SCHED; PG8_LDA(At, 0, 0); PG8_STAGE(PG8_SA(1, 1), a1 + hstep, voffA);
            PG8_WAIT_V(8); PG8_WAIT_L(0); PG8_BAR; PG8_MMA(0, 0, At, B0); PG8_MMA(0, 1, At, B1); PG8_BAR; PG8_SCHED;
            PG8_LDA(At, 0, 1); PG8_STAGE(PG8_SB(0, 0), b2, voffB); PG8_STAGE(PG8_SB(0, 1), b2 + hstep, voffB); PG8_STAGE(PG8_SA(0, 0), a2, voffA);
            PG8_WAIT_V(8); PG8_WAIT_L(0); PG8_BAR; PG8_MMA(1, 0, At, B0); PG8_MMA(1, 1, At, B1); PG8_BAR; PG8_SCHED;
            PG8_LDB(B0, 1, 0); PG8_LDB(B1, 1, 1); PG8_SCHED; PG8_LDA(At, 1, 0); PG8_STAGE(PG8_SA(0, 1), a2 + hstep, voffA);
            PG8_WAIT_V(8); PG8_WAIT_L(0); PG8_BAR; PG8_MMA(0, 0, At, B0); PG8_MMA(0, 1, At, B1); PG8_BAR; PG8_SCHED;
            PG8_LDA(At, 1, 1); PG8_STAGE(PG8_SB(1, 0), b3, voffB); PG8_STAGE(PG8_SB(1, 1), b3 + hstep, voffB); PG8_STAGE(PG8_SA(1, 0), a3, voffA);
            PG8_WAIT_V(8); PG8_WAIT_L(0); PG8_BAR; PG8_MMA(1, 0, At, B0); PG8_MMA(1, 1, At, B1); PG8_BAR; PG8_SCHED;
            } else {
            PG8_LDB(B0, 0, 0); PG8_SCHED; PG8_LDA(At, 0, 0); PG8_STAGE(PG8_SA(1, 1), a1 + hstep, voffA);
            PG8_WAIT_L(8); PG8_BAR; PG8_WAIT_L(0); PG8_MMA(0, 0, At, B0); PG8_BAR; PG8_SCHED;
            PG8_LDB(B1, 0, 1); PG8_STAGE(PG8_SB(0, 0), b2, voffB);
            PG8_BAR; PG8_WAIT_L(0); PG8_MMA(0, 1, At, B1); PG8_BAR;
            PG8_LDA(At, 0, 1); PG8_STAGE(PG8_SA(0, 0), a2, voffA);
            PG8_BAR; PG8_WAIT_L(0); PG8_MMA(1, 0, At, B0); PG8_BAR; PG8_SCHED;
            PG8_STAGE(PG8_SB(0, 1), b2 + hstep, voffB);
            PG8_WAIT_V(6); PG8_BAR; PG8_MMA(1, 1, At, B1); PG8_BAR;
            PG8_LDB(B0, 1, 0); PG8_SCHED; PG8_LDA(At, 1, 0); PG8_STAGE(PG8_SA(0, 1), a2 + hstep, voffA);
            PG8_WAIT_L(8); PG8_BAR; PG8_WAIT_L(0); PG8_MMA(0, 0, At, B0); PG8_BAR; PG8_SCHED;
            PG8_LDB(B1, 1, 1); PG8_STAGE(PG8_SB(1, 0), b3, voffB);
            PG8_BAR; PG8_WAIT_L(0); PG8_MMA(0, 1, At, B1); PG8_BAR;
            PG8_LDA(At, 1, 1); PG8_STAGE(PG8_SA(1, 0), a3, voffA);
            PG8_BAR; PG8_WAIT_L(0); PG8_MMA(1, 0, At, B0); PG8_BAR; PG8_SCHED;
            PG8_STAGE(PG8_SB(1, 1), b3 + hstep, voffB);
            PG8_WAIT_V(6); PG8_BAR; PG8_MMA(1, 1, At, B1); PG8_BAR;
            }
        }
        if constexpr (ALIGN_EPI) { if (wr == 0) PG8_BAR; }
        if constexpr (!Epi::AFTER_DRAIN) { E(acc, cur, wr, wc, fr, fq); S.done(cur); }
        if (!has_next) break;
#pragma unroll
        for (int a = 0; a < 2; ++a)
#pragma unroll
            for (int b = 0; b < 2; ++b)
#pragma unroll
                for (int m = 0; m < 4; ++m)
#pragma unroll
                    for (int n = 0; n < 2; ++n) acc[a][b][m][n] = (f32x4){0.f, 0.f, 0.f, 0.f};
        cur = nxt; cA = nA; cB = nB; ++ui;
        if constexpr (ALIGN_EPI) { if (wr == 1) PG8_BAR; }
    }
    PG8_WAIT_V(0);
    if constexpr (!ALIGN_EPI) { if (wr == 0) PG8_BAR; }
    PG8_BAR;
    if constexpr (Epi::AFTER_DRAIN) { E.fused(acc, cur, wr, wc, fr, fq, lds, wid, lane); S.done(cur); }
#undef PG8_SA
#undef PG8_SB
#undef PG8_STAGE
#undef PG8_LDA
#undef PG8_LDB
#undef PG8_MMA
#undef PG8_WAIT_V
#undef PG8_WAIT_L
#undef PG8_BAR
#undef PG8_SCHED
}
}
constexpr int SEQ = 16384, NB = 2, T = NB * SEQ, DM = 1024, DFF = 2816, MEMT = 256;
constexpr int ZW = 1280;
constexpr float EPS = 1e-6f, LOG2E = 1.4426950408889634f;
constexpr int NTHREADS = 512;
constexpr int LDS_BYTES = 135168;

typedef unsigned short bf16;
typedef short bf16x8 __attribute__((ext_vector_type(8)));
typedef float f32x16 __attribute__((ext_vector_type(16)));
typedef float f32x4 __attribute__((ext_vector_type(4)));
typedef unsigned u32x4 __attribute__((ext_vector_type(4)));
typedef unsigned u32x2 __attribute__((ext_vector_type(2)));
#define LAS __attribute__((address_space(3)))

constexpr size_t MiB = 1u << 20;
constexpr size_t W_WIN = 0;
constexpr size_t W_WUQ = W_WIN + (size_t)ZW * 1024 * 2;
constexpr size_t W_WUKV = W_WUQ + (size_t)768 * 256 * 2;
constexpr size_t W_WO0 = W_WUKV + (size_t)1024 * 128 * 2;
constexpr size_t W_WQKV = W_WO0 + (size_t)1024 * 1024 * 2;
constexpr size_t W_WDO = W_WQKV + (size_t)3072 * 1024 * 2;
constexpr size_t W_WMQ = W_WDO + (size_t)1024 * 1024 * 2;
constexpr size_t W_WMKV = W_WMQ + (size_t)2 * 512 * 1024 * 2;
constexpr size_t W_WMO = W_WMKV + (size_t)2 * 1024 * 1024 * 2;
constexpr size_t W_WGU = W_WMO + (size_t)2 * 1024 * 512 * 2;
constexpr size_t W_WD = W_WGU + (size_t)2 * 5632 * 1024 * 2;
constexpr size_t W_END = W_WD + (size_t)2 * 1024 * 2816 * 2;
static_assert(W_END <= 55 * MiB, "weights");
constexpr size_t S_MN = 55 * MiB;
constexpr size_t S_MKV = 57 * MiB;
constexpr size_t S_MK = 59 * MiB;
constexpr size_t S_VTM = 60 * MiB;
constexpr size_t S_ROPE = 61 * MiB;
constexpr size_t S_LAM = 65 * MiB;
constexpr size_t A_XN = 66 * MiB;
constexpr size_t A_S = 130 * MiB;
constexpr size_t A_Z = A_S, A_QA = A_S + 80 * MiB, A_KA = A_S + 112 * MiB, A_VTA = A_S + 120 * MiB, A_CQN = A_S + 128 * MiB, A_CKVN = A_S + 144 * MiB,
                 A_QF = A_S + 152 * MiB, A_QB = A_S + 200 * MiB, A_KB = A_S + 248 * MiB, A_VTB = A_S + 296 * MiB, A_KV = A_XN, A_ATT = A_S;
constexpr size_t A_QM = A_S, A_MO = A_S + 32 * MiB, A_H = A_S;
constexpr size_t A_QKV = A_S, A_XH = A_S + 192 * MiB  , A_VTD = A_XN, A_O1 = A_S, A_O2 = A_S + 64 * MiB, A_DO = A_S + 128 * MiB;
constexpr size_t WS_NEED = A_S + 328 * MiB;

__device__ __forceinline__ unsigned f2bf(float f) { unsigned u = __builtin_bit_cast(unsigned, f); return (u + 0x7fffu + ((u >> 16) & 1u)) >> 16; }
typedef float f32x2 __attribute__((ext_vector_type(2))); typedef __bf16 bf16x2_t __attribute__((ext_vector_type(2)));
__device__ __forceinline__ unsigned pk2(float lo, float hi) { f32x2 v = {lo, hi}; bf16x2_t b = __builtin_convertvector(v, bf16x2_t); return __builtin_bit_cast(unsigned, b); }
__device__ __forceinline__ float bflo(unsigned w) { return __builtin_bit_cast(float, w << 16); }
__device__ __forceinline__ float bfhi(unsigned w) { return __builtin_bit_cast(float, w & 0xffff0000u); }
#define UNPK8(v, f) do { f[0] = bflo(v.x); f[1] = bfhi(v.x); f[2] = bflo(v.y); f[3] = bfhi(v.y); f[4] = bflo(v.z); f[5] = bfhi(v.z); f[6] = bflo(v.w); f[7] = bfhi(v.w); } while (0)
#define PACK8(v, f) do { v.x = pk2(f[0], f[1]); v.y = pk2(f[2], f[3]); v.z = pk2(f[4], f[5]); v.w = pk2(f[6], f[7]); } while (0)
__device__ __forceinline__ float shfl_xor_l(float v, int o, int lane) { return __builtin_bit_cast(float, __builtin_amdgcn_ds_bpermute((lane ^ o) << 2, __builtin_bit_cast(int, v))); }
__device__ __forceinline__ float wave_sum(float v, int lane) {
#pragma unroll
    for (int o = 1; o < 64; o <<= 1) v += shfl_xor_l(v, o, lane);
    return v;
}

struct Args { const float* in[32]; float* out; unsigned char* ws; int ph_lo, ph_hi; };

__device__ __forceinline__ void transpose_item(const float* W, int K, int N, bf16* WT, int mode, LAS float* scr, int item, int lane) {
    const int nblk = N / 32, kb = item / nblk, nb = item % nblk, k0 = 64 * kb, n0 = 32 * nb;
    const int drow0 = (mode == 0) ? n0 : (mode == 3) ? ((n0 < 2048) ? 256 * (n0 >> 8) + 128 * ((n0 >> 5) & 1) + 32 * ((n0 >> 6) & 3) : n0)
                                              : (256 * (n0 >> 7) + (n0 & 127) + (mode == 2 ? 128 : 0));
#pragma unroll 8
    for (int i = 0; i < 32; ++i) { const int kk = 2 * i + (lane >> 5); scr[kk * 33 + (lane & 31)] = W[(size_t)(k0 + kk) * N + n0 + (lane & 31)]; }
    asm volatile("s_waitcnt lgkmcnt(0)" ::: "memory");
    const int c = lane & 7;
#pragma unroll
    for (int j = 0; j < 4; ++j) { const int n = (lane >> 3) + 8 * j; const LAS float* s = scr + (8 * c) * 33 + n;
        u32x4 o; o.x = pk2(s[0 * 33], s[1 * 33]); o.y = pk2(s[2 * 33], s[3 * 33]); o.z = pk2(s[4 * 33], s[5 * 33]); o.w = pk2(s[6 * 33], s[7 * 33]);
        *(u32x4*)(WT + (size_t)(drow0 + n) * K + k0 + 8 * c) = o; }
    asm volatile("s_waitcnt lgkmcnt(0)" ::: "memory");
}


__device__ __forceinline__ float chunk_ss(const u32x4 v) { float f[8]; UNPK8(v, f); float s = 0.f;
#pragma unroll
    for (int i = 0; i < 8; ++i) s += f[i] * f[i];
    return s; }
__device__ __forceinline__ u32x4 chunk_scale(const u32x4 v, float r, const float* g) { float f[8]; UNPK8(v, f);
    const f32x4 g0 = ((const f32x4*)g)[0], g1 = ((const f32x4*)g)[1];
    f[0] *= r * g0.x; f[1] *= r * g0.y; f[2] *= r * g0.z; f[3] *= r * g0.w; f[4] *= r * g1.x; f[5] *= r * g1.y; f[6] *= r * g1.z; f[7] *= r * g1.w;
    u32x4 o; PACK8(o, f); return o; }

__device__ __forceinline__ void norm_row_1024(const float* xrow, const float* gain, bf16* orow, int lane) {
    const f32x4* xr = (const f32x4*)xrow + lane; const f32x4* gr = (const f32x4*)gain + lane;
    f32x4 v[4]; float s = 0.f;
#pragma unroll
    for (int j = 0; j < 4; ++j) { v[j] = xr[64 * j]; s += (v[j].x * v[j].x + v[j].y * v[j].y) + (v[j].z * v[j].z + v[j].w * v[j].w); }
    const float rstd = 1.0f / sqrtf(wave_sum(s, lane) * (1.f / 1024.f) + EPS);
    unsigned long long* o8 = (unsigned long long*)orow + lane;
#pragma unroll
    for (int j = 0; j < 4; ++j) { const f32x4 g = gr[64 * j];
        o8[64 * j] = (unsigned long long)pk2(v[j].x * rstd * g.x, v[j].y * rstd * g.y) | ((unsigned long long)pk2(v[j].z * rstd * g.z, v[j].w * rstd * g.w) << 32); }
}
__device__ __forceinline__ void norm_row_1024_h(const bf16* xrow, const float* gain, bf16* orow, int lane) {
    u32x4 v[2]; float s = 0.f;
#pragma unroll
    for (int j = 0; j < 2; ++j) { v[j] = ((const u32x4*)xrow)[lane + 64 * j]; s += chunk_ss(v[j]); }
    const float rstd = 1.0f / sqrtf(wave_sum(s, lane) * (1.f / 1024.f) + EPS);
#pragma unroll
    for (int j = 0; j < 2; ++j) ((u32x4*)orow)[lane + 64 * j] = chunk_scale(v[j], rstd, gain + 8 * (lane + 64 * j));
}
__device__ __forceinline__ void norm_phase_h(const bf16* X, const float* gain, bf16* XN, int gw, int NGW, int lane) {
    for (int m = gw; m < T; m += NGW) norm_row_1024_h(X + (size_t)m * DM, gain, XN + (size_t)m * DM, lane);
}
__device__ __forceinline__ void norm_phase(const float* X, const float* gain, bf16* XN, int gw, int NGW, int lane) {
    for (int m = gw; m < T; m += NGW) norm_row_1024(X + (size_t)m * DM, gain, XN + (size_t)m * DM, lane);
}

template <int N> __device__ __forceinline__ void rms_group(const bf16* src, bf16* dst, const float* gain, float oscale) {
    float ss = 0.f;
#pragma unroll 4
    for (int c = 0; c < N / 8; ++c) { const u32x4 v = ((const u32x4*)src)[c]; float f[8]; UNPK8(v, f);
#pragma unroll
        for (int i = 0; i < 8; ++i) ss += f[i] * f[i]; }
    const float r = (1.0f / sqrtf(ss * (1.f / N) + EPS)) * oscale;
#pragma unroll 4
    for (int c = 0; c < N / 8; ++c) { const u32x4 v = ((const u32x4*)src)[c]; float f[8]; UNPK8(v, f);
        const f32x4 g0 = ((const f32x4*)gain)[2 * c], g1 = ((const f32x4*)gain)[2 * c + 1];
        f[0] *= r * g0.x; f[1] *= r * g0.y; f[2] *= r * g0.z; f[3] *= r * g0.w; f[4] *= r * g1.x; f[5] *= r * g1.y; f[6] *= r * g1.z; f[7] *= r * g1.w;
        u32x4 o; PACK8(o, f); ((u32x4*)dst)[c] = o; }
}

__device__ __forceinline__ void mla_head_item(const bf16* srcA, const bf16* srcB, bf16* dst, const float* gain, float oscale, const float2* rope) {
    float ss = 0.f;
#pragma unroll
    for (int c = 0; c < 8; ++c) { const u32x4 v = ((const u32x4*)srcA)[c]; float f[8]; UNPK8(v, f);
#pragma unroll
        for (int i = 0; i < 8; ++i) ss += f[i] * f[i]; }
#pragma unroll
    for (int c = 0; c < 4; ++c) { const u32x4 v = ((const u32x4*)srcB)[c]; float f[8]; UNPK8(v, f);
#pragma unroll
        for (int i = 0; i < 8; ++i) ss += f[i] * f[i]; }
    const float r = (1.0f / sqrtf(ss * (1.f / 96.f) + EPS)) * oscale;
#pragma unroll
    for (int c = 0; c < 8; ++c) { const u32x4 v = ((const u32x4*)srcA)[c]; float f[8]; UNPK8(v, f);
#pragma unroll
        for (int i = 0; i < 8; ++i) f[i] *= r * gain[8 * c + i];
        u32x4 o; PACK8(o, f); ((u32x4*)dst)[c] = o; }
#pragma unroll
    for (int hc = 0; hc < 2; ++hc) {
        const u32x4 v1 = ((const u32x4*)srcB)[hc], v2 = ((const u32x4*)srcB)[2 + hc]; float x1[8], x2[8], o1[8], o2[8]; UNPK8(v1, x1); UNPK8(v2, x2);
#pragma unroll
        for (int i = 0; i < 8; ++i) { const float a = x1[i] * r * gain[64 + 8 * hc + i], b = x2[i] * r * gain[80 + 8 * hc + i]; const float2 cs = rope[8 * hc + i];
            o1[i] = a * cs.x - b * cs.y; o2[i] = b * cs.x + a * cs.y; }
        u32x4 w1, w2; PACK8(w1, o1); PACK8(w2, o2); ((u32x4*)dst)[8 + hc] = w1; ((u32x4*)dst)[10 + hc] = w2; }
}

template <int NC>
__device__ __forceinline__ void transpose_tiles(LAS unsigned char* lds, const bf16* src, int pitch, int cbase, int cstride, int nct, bf16* dst, int W, int slen, int nrows, int bid_, int G_, int tid) {
    constexpr int LS = NC * 64 + 8;
    const int nsc = nct / NC, nst = (nrows / 64) * nsc;
    LAS bf16* tl = (LAS bf16*)lds;
    for (int st = bid_; st < nst; st += G_) {
        const int rt = st / nsc, sc = st % nsc, r0 = rt * 64, b = r0 / slen, t0 = r0 % slen;
        { const int tok = tid >> 3, ch = tid & 7; u32x4 v[NC];
#pragma unroll
          for (int i = 0; i < NC; ++i) v[i] = *(const u32x4*)(src + (size_t)(r0 + tok) * pitch + cbase + (sc * NC + i) * cstride + ch * 8);
#pragma unroll
          for (int i = 0; i < NC; ++i) *(LAS u32x4*)(tl + tok * LS + i * 64 + ch * 8) = v[i]; }
        __syncthreads();
        { const int col = tid >> 3, tc = tid & 7;
#pragma unroll
          for (int i = 0; i < NC; ++i) { unsigned w[4];
#pragma unroll
              for (int k = 0; k < 4; ++k) { const unsigned lo = tl[(tc * 8 + 2 * k) * LS + i * 64 + col], hi = tl[(tc * 8 + 2 * k + 1) * LS + i * 64 + col]; w[k] = lo | (hi << 16); }
              u32x4 o; o.x = w[0]; o.y = w[1]; o.z = w[2]; o.w = w[3];
              *(u32x4*)(dst + ((size_t)b * W + (sc * NC + i) * 64 + col) * slen + t0 + tc * 8) = o; } }
        __syncthreads();
    }
}

constexpr int AF_CAUSAL = 1, AF_WINDOW = 2, AF_ALIBI = 4, AF_SINK = 8, AF_QNORM = 16, AF_ROBUST = 32, AF_REV = 64;
#define MX3(a, b, c) __builtin_fmaxf(__builtin_fmaxf((a), (b)), (c))
constexpr int SWA_W = 128;
__device__ __forceinline__ bf16x8 pack_bf16x8(const f32x16& p, int base) {
    u32x4 w; w.x = pk2(p[base + 0], p[base + 1]); w.y = pk2(p[base + 2], p[base + 3]); w.z = pk2(p[base + 4], p[base + 5]); w.w = pk2(p[base + 6], p[base + 7]);
    return __builtin_bit_cast(bf16x8, w);
}
template <int DQK, int DV, int FLAGS, int qp, int kp, int vts, int op>
__device__ __forceinline__ void attn_unit(LAS unsigned char* lds, const bf16* Q, const bf16* K, const bf16* VT, bf16* O,
                                          int q0, int kt_lo, int kt_hi, float slope2, float sink2, const float* qgain, float qscale, bool skipmax = false) {
    constexpr int KROW = DQK * 2 + 16, VROW = 144, KT_BYTES = 64 * KROW, VT_BYTES = DV * VROW, BUF = KT_BYTES + VT_BYTES;
    constexpr int KC = DQK / 8, KCH = 64 * KC, VCH = DV * 8, KPT = (KCH + NTHREADS - 1) / NTHREADS, VPT = VCH / NTHREADS, ND0 = DQK / 16, NDB = DV / 32;
    static_assert(2 * BUF <= LDS_BYTES, "attention LDS");
    int tid_o = threadIdx.x; asm volatile("" : "+v"(tid_o));
    const int tid = tid_o, lane = tid & 63, r32 = lane & 31, hi = lane >> 5; const int wave = __builtin_amdgcn_readfirstlane(tid >> 6);
    bf16x8 qr[ND0];
    { const bf16* qrow = Q + (size_t)(32 * wave + r32) * qp + 8 * hi;
#pragma unroll
      for (int d0 = 0; d0 < ND0; ++d0) qr[d0] = *(const bf16x8*)(qrow + 16 * d0);
      if (FLAGS & AF_QNORM) {
          float ss = 0.f;
#pragma unroll
          for (int d0 = 0; d0 < ND0; ++d0) { const u32x4 v = __builtin_bit_cast(u32x4, qr[d0]); float f[8]; UNPK8(v, f);
#pragma unroll
              for (int i = 0; i < 8; ++i) ss += f[i] * f[i]; }
          ss += shfl_xor_l(ss, 32, lane);
          const float r = (1.0f / sqrtf(ss * (1.f / DQK) + EPS)) * qscale;
#pragma unroll
          for (int d0 = 0; d0 < ND0; ++d0) { const u32x4 v = __builtin_bit_cast(u32x4, qr[d0]); float f[8]; UNPK8(v, f);
#pragma unroll
              for (int i = 0; i < 8; ++i) f[i] *= r * qgain[16 * d0 + 8 * hi + i];
              u32x4 o; PACK8(o, f); qr[d0] = __builtin_bit_cast(bf16x8, o); }
      } }
    const int qpos = q0 + 32 * wave + r32, qmin_w = q0 + 32 * wave, qmax_w = qmin_w + 31;
    f32x16 o[NDB];
#pragma unroll
    for (int d = 0; d < NDB; ++d)
#pragma unroll
        for (int r = 0; r < 16; ++r) o[d][r] = 0.f;
    float m = (FLAGS & AF_ROBUST) ? -1e30f : 0.f, l = 0.f;
    f32x16 negm;
#pragma unroll
    for (int r = 0; r < 16; ++r) negm[r] = 0.f;
    u32x4 kreg[KPT], vreg[VPT];
    unsigned kgo[KPT], vgo[VPT], klo[KPT], vlo[VPT];
#pragma unroll
    for (int i = 0; i < KPT; ++i) { const int c = tid + i * NTHREADS; const int row = c / KC, cc = c % KC; kgo[i] = (unsigned)(row * kp + cc * 8) * 2u; klo[i] = (unsigned)(row * KROW + cc * 16); }
#pragma unroll
    for (int i = 0; i < VPT; ++i) { const int c = tid + i * NTHREADS; const int d = c >> 3, cc = c & 7; vgo[i] = (unsigned)(d * vts + cc * 8) * 2u; vlo[i] = (unsigned)(KT_BYTES + d * VROW + cc * 16); }
#define ATT_GLOAD(t) do { const char* kt_ = (const char*)(K + (size_t)(t) * 64 * kp); const char* vt_ = (const char*)(VT + (size_t)(t) * 64); \
        _Pragma("unroll") for (int i = 0; i < KPT; ++i) { if (KCH % NTHREADS == 0 || tid + i * NTHREADS < KCH) kreg[i] = *(const u32x4*)(kt_ + kgo[i]); } \
        _Pragma("unroll") for (int i = 0; i < VPT; ++i) vreg[i] = *(const u32x4*)(vt_ + vgo[i]); } while (0)
#define ATT_LSTORE(buf) do { LAS unsigned char* b_ = lds + (buf) * BUF; \
        _Pragma("unroll") for (int i = 0; i < KPT; ++i) { if (KCH % NTHREADS == 0 || tid + i * NTHREADS < KCH) *(LAS u32x4*)(b_ + klo[i]) = kreg[i]; } \
        _Pragma("unroll") for (int i = 0; i < VPT; ++i) *(LAS u32x4*)(b_ + vlo[i]) = vreg[i]; } while (0)
    ATT_GLOAD((FLAGS & AF_REV) ? kt_hi - 1 : kt_lo); ATT_LSTORE(0);
    __syncthreads();
    bool started = false;
    const int prow = (r32 & ~12) | ((r32 & 4) << 1) | ((r32 & 8) >> 1);
    const int ntile = kt_hi - kt_lo;
    for (int it = 0; it < ntile; ++it) {
        const int t = (FLAGS & AF_REV) ? kt_hi - 1 - it : kt_lo + it;
        const int cur = it & 1;
        const bool more = (it + 1 < ntile);
        const int kv0 = t * 64;
        bool skip = false;
        if (FLAGS & AF_CAUSAL) skip = skip || (kv0 > qmax_w);
        if (FLAGS & AF_WINDOW) skip = skip || (kv0 + 63 < qmin_w - (SWA_W - 1));
        if (!skip) {
            const LAS unsigned char* kb = lds + cur * BUF + prow * KROW + 16 * hi;
            const LAS unsigned char* vb = lds + cur * BUF + KT_BYTES + r32 * VROW + 16 * hi;
            f32x16 p0, p1;
            bf16x8 kf[2][4];
#pragma unroll
            for (int i = 0; i < 2; ++i) { kf[0][2 * i] = *(const LAS bf16x8*)(kb + i * 32); kf[0][2 * i + 1] = *(const LAS bf16x8*)(kb + 32 * KROW + i * 32); }
            const int nrel = qpos - kv0 - 8 * hi;
            if (FLAGS & AF_ALIBI) { const float ab = -slope2 * (float)nrel - ((FLAGS & AF_ROBUST) ? 0.f : m);
#pragma unroll
                for (int r = 0; r < 16; ++r) { const float c = (float)(16 * (r >> 3) + (r & 7)); p0[r] = __builtin_fmaf(slope2, c, ab); p1[r] = __builtin_fmaf(slope2, c + 32.f, ab); }
            } else if (FLAGS & AF_ROBUST) {
#pragma unroll
                for (int r = 0; r < 16; ++r) { p0[r] = 0.f; p1[r] = 0.f; }
            } else { p0 = negm; p1 = negm; }
            __builtin_amdgcn_sched_barrier(0);
#pragma unroll
            for (int c = 0; c < ND0 / 2; ++c) {
                if (c + 1 < ND0 / 2) {
#pragma unroll
                    for (int i = 0; i < 2; ++i) { kf[(c + 1) & 1][2 * i] = *(const LAS bf16x8*)(kb + (2 * c + 2 + i) * 32); kf[(c + 1) & 1][2 * i + 1] = *(const LAS bf16x8*)(kb + 32 * KROW + (2 * c + 2 + i) * 32); }
                }
#pragma unroll
                for (int i = 0; i < 2; ++i) {
                    p0 = __builtin_amdgcn_mfma_f32_32x32x16_bf16(kf[c & 1][2 * i], qr[2 * c + i], p0, 0, 0, 0);
                    p1 = __builtin_amdgcn_mfma_f32_32x32x16_bf16(kf[c & 1][2 * i + 1], qr[2 * c + i], p1, 0, 0, 0);
                }
                __builtin_amdgcn_sched_barrier(0);
            }
            if (more) ATT_GLOAD((FLAGS & AF_REV) ? t - 1 : t + 1);
            bf16x8 vf[2][4];
#pragma unroll
            for (int ks = 0; ks < 4; ++ks) vf[0][ks] = *(const LAS bf16x8*)(vb + ks * 32);
            __builtin_amdgcn_sched_barrier(0);
            bool need_mask = false;
            if (FLAGS & AF_CAUSAL) need_mask = need_mask || (kv0 + 63 > qmin_w);
            if (FLAGS & AF_WINDOW) need_mask = need_mask || (kv0 < qmax_w - (SWA_W - 1));
            if (need_mask) {
#pragma unroll
                for (int r = 0; r < 16; ++r) { const int c = 16 * (r >> 3) + (r & 7);
                    bool m0 = false, m1 = false;
                    if (FLAGS & AF_CAUSAL) { m0 = m0 || (c > nrel); m1 = m1 || (c + 32 > nrel); }
                    if (FLAGS & AF_WINDOW) { m0 = m0 || (c <= nrel - SWA_W); m1 = m1 || (c + 32 <= nrel - SWA_W); }
                    if (m0) p0[r] = -INFINITY; if (m1) p1[r] = -INFINITY; }
            }
            float mx = 0.f;
            if ((FLAGS & AF_ROBUST) || !started || !skipmax) {
              float a = MX3(p0[0], p0[1], p1[0]), b = MX3(p0[2], p0[3], p1[1]); a = MX3(a, p1[2], p1[3]);
#pragma unroll
              for (int r = 4; r < 16; r += 4) { a = MX3(a, p0[r], p0[r + 1]); b = MX3(b, p0[r + 2], p0[r + 3]); a = MX3(a, p1[r], p1[r + 1]); b = MX3(b, p1[r + 2], p1[r + 3]); }
              mx = __builtin_fmaxf(a, b);
              if ((FLAGS & AF_ROBUST) || !started) mx = __builtin_fmaxf(mx, shfl_xor_l(mx, 32, lane)); }
            if (FLAGS & AF_ROBUST) {
                if (__any(mx > m + 8.0f)) {
                    const float mn = fmaxf(m, mx), alpha = __builtin_amdgcn_exp2f(m - mn);
                    l *= alpha; m = mn;
#pragma unroll
                    for (int d = 0; d < NDB; ++d)
#pragma unroll
                        for (int r = 0; r < 16; ++r) o[d][r] *= alpha;
                }
#pragma unroll
                for (int r = 0; r < 16; ++r) { p0[r] -= m; p1[r] -= m; }
            } else {
                if (!started) {
                    started = true;
                    m = mx;
#pragma unroll
                    for (int r = 0; r < 16; ++r) { p0[r] -= mx; p1[r] -= mx; }
                    if (!(FLAGS & AF_ALIBI)) {
#pragma unroll
                        for (int r = 0; r < 16; ++r) negm[r] = -m;
                    }
                } else if (!skipmax && __any(mx > 64.0f)) {
                    mx = __builtin_fmaxf(mx, shfl_xor_l(mx, 32, lane));
                    const float dl = __builtin_fmaxf(mx, 0.f), alpha = __builtin_amdgcn_exp2f(-dl);
                    m += dl; l *= alpha;
#pragma unroll
                    for (int r = 0; r < 16; ++r) { p0[r] -= dl; p1[r] -= dl; }
#pragma unroll
                    for (int d = 0; d < NDB; ++d)
#pragma unroll
                        for (int r = 0; r < 16; ++r) o[d][r] *= alpha;
                    if (!(FLAGS & AF_ALIBI)) {
#pragma unroll
                        for (int r = 0; r < 16; ++r) negm[r] = -m;
                    }
                }
            }
            f32x2 rs2 = {0.f, 0.f};
#pragma unroll
            for (int r = 0; r < 16; ++r) { p0[r] = __builtin_amdgcn_exp2f(p0[r]); p1[r] = __builtin_amdgcn_exp2f(p1[r]); }
#pragma unroll
            for (int r = 0; r < 16; r += 2) { rs2 += (f32x2){p0[r], p0[r + 1]}; rs2 += (f32x2){p1[r], p1[r + 1]}; }
            l += rs2.x + rs2.y;
            bf16x8 pf[4];
            pf[0] = pack_bf16x8(p0, 0); pf[1] = pack_bf16x8(p0, 8); pf[2] = pack_bf16x8(p1, 0); pf[3] = pack_bf16x8(p1, 8);
            __builtin_amdgcn_sched_barrier(0);
#pragma unroll
            for (int d = 0; d < NDB; ++d) {
                if (d + 1 < NDB) {
#pragma unroll
                    for (int ks = 0; ks < 4; ++ks) vf[(d + 1) & 1][ks] = *(const LAS bf16x8*)(vb + (d + 1) * 32 * VROW + ks * 32);
                }
#pragma unroll
                for (int ks = 0; ks < 4; ++ks) o[d] = __builtin_amdgcn_mfma_f32_32x32x16_bf16(vf[d & 1][ks], pf[ks], o[d], 0, 0, 0);
                __builtin_amdgcn_sched_barrier(0);
            }
        }
        if (skip && more) ATT_GLOAD((FLAGS & AF_REV) ? t - 1 : t + 1);
        if (more) ATT_LSTORE(cur ^ 1);
        __syncthreads();
    }
#undef ATT_GLOAD
#undef ATT_LSTORE
    float lt = l + shfl_xor_l(l, 32, lane);
    if (FLAGS & AF_SINK) lt += __builtin_amdgcn_exp2f(sink2 - m);
    const float inv = 1.0f / lt;
    bf16* orow = O + (size_t)(32 * wave + r32) * op + 4 * hi;
#pragma unroll
    for (int d = 0; d < NDB; ++d)
#pragma unroll
        for (int g = 0; g < 4; ++g) {
            u32x2 w; w.x = pk2(o[d][4 * g] * inv, o[d][4 * g + 1] * inv); w.y = pk2(o[d][4 * g + 2] * inv, o[d][4 * g + 3] * inv);
            *(u32x2*)(orow + 32 * d + 8 * g) = w;
        }
}

__device__ __forceinline__ void causal_slot(int j, int NCPC, int& combo, int& qb) {
    const int i = j >> 8, c = j & 255, vc = (c & 7) * 32 + (c >> 3);
    combo = vc / NCPC; const int s = vc % NCPC, g = i >> 1;
    qb = (i & 1) ? (2 * NCPC * (g + 1) - 1 - s) : (2 * NCPC * g + s);
}

template <class Epi> __device__ __forceinline__ void run_gemm(LAS unsigned char* lds, const bf16* A, const bf16* Bt, int M, int N, int K, const Epi& E, int cid) {
    pg8::Gemm g{A, Bt, M, N, K}; pg8::StaticOrder S; S.init(M, N, (int)gridDim.x, cid);
#ifdef NO_RESID
    if constexpr (__is_same(Epi, pg8::EpiResid)) return;
#endif
#ifdef NO_SWIGLU
    if constexpr (__is_same(Epi, pg8::EpiSwiglu)) return;
#endif
#ifdef NO_STORE
    if constexpr (__is_same(Epi, pg8::EpiStore)) return;
#endif
#ifndef NO_GEMM
    pg8::gemm_phase<Epi, pg8::StaticOrder, true, true>(lds, g, S, E);
#endif
}

#define XB_TMO      128
#define XB_XCNT(j)  (256  + 64 * (j))
#define XB_XSUB(j)  (1280 + 64 * (j))
#define XB_XGEN(j)  (2304 + 64 * (j))
#define XB_TOP      3328
#define XB_TOPGEN   3392
#define XCD_BAR_WORDS 3456
#define XB_SPIN_CAP (1u << 18)

__device__ __forceinline__ unsigned xb_ld(unsigned* p)              { return __hip_atomic_load(p, __ATOMIC_RELAXED, __HIP_MEMORY_SCOPE_AGENT); }
__device__ __forceinline__ unsigned xb_add(unsigned* p, unsigned v) { return __hip_atomic_fetch_add(p, v, __ATOMIC_RELAXED, __HIP_MEMORY_SCOPE_AGENT); }
__device__ __forceinline__ unsigned xb_xcc_id() { return (unsigned)__builtin_amdgcn_s_getreg((3 << 11) | 20) & 0xFu; }
#define XB_SPIN(cond, bar) do { unsigned _sp = 0; while (cond) { __builtin_amdgcn_s_sleep(1); \
    if ((++_sp & 255u) == 0u) { if (xb_ld(&(bar)[XB_TMO])) break; if (_sp > XB_SPIN_CAP) { atomicAdd(&(bar)[XB_TMO], 1u); break; } } } } while (0)

struct XcdBarrier {
    unsigned* bar; unsigned x;
    volatile LAS unsigned* st;
};

__device__ __forceinline__ XcdBarrier xcd_barrier_post(unsigned* bar, volatile LAS unsigned* st) {
    XcdBarrier b; b.bar = bar; b.x = xb_xcc_id(); b.st = st;
    if (threadIdx.x == 0) (void)xb_add(&bar[XB_XCNT(b.x)], 1u);
    return b;
}
__device__ __forceinline__ void xcd_barrier_complete(unsigned* bar, unsigned x, unsigned& nloc, unsigned& nx) {
    const unsigned G = gridDim.x * gridDim.y * gridDim.z;
    unsigned sum, cnt, mine, sp = 0u;
    for (;;) {
        sum = 0u; cnt = 0u; mine = 0u;
#pragma unroll
        for (unsigned j = 0; j < 16; ++j) { const unsigned c = xb_ld(&bar[XB_XCNT(j)]); sum += c; cnt += (c > 0u) ? 1u : 0u; mine = (j == x) ? c : mine; }
        if (sum == G) break;
        __builtin_amdgcn_s_sleep(1);
        if ((++sp & 255u) == 0u) { if (xb_ld(&bar[XB_TMO])) break; if (sp > XB_SPIN_CAP) { atomicAdd(&bar[XB_TMO], 1u); break; } }
    }
    nloc = mine > 0u ? mine : 1u; nx = cnt > 0u ? cnt : 1u;
}

__device__ __forceinline__ void xcd_barrier(const XcdBarrier& b) {
    asm volatile("s_waitcnt vmcnt(0)" ::: "memory");
    __syncthreads();
    if (threadIdx.x == 0) {
        unsigned* bar = b.bar;
        __builtin_amdgcn_s_waitcnt(0);
        unsigned nloc = b.st[0], nx = b.st[1];
        if (nloc == 0u) { xcd_barrier_complete(bar, b.x, nloc, nx); b.st[0] = nloc; b.st[1] = nx; }
        const unsigned old = xb_add(&bar[XB_XSUB(b.x)], 1u);
        const unsigned gen = old / nloc;
        if (old + 1u == (gen + 1u) * nloc) {
            __builtin_amdgcn_fence(__ATOMIC_RELEASE, "agent");
            asm volatile("s_waitcnt vmcnt(0)" ::: "memory");
            const unsigned og = xb_add(&bar[XB_TOP], 1u);
            const unsigned tg = og / nx;
            if (og + 1u == (tg + 1u) * nx) xb_add(&bar[XB_TOPGEN], 1u);
            else XB_SPIN(xb_ld(&bar[XB_TOPGEN]) == tg, bar);
            __builtin_amdgcn_fence(__ATOMIC_ACQUIRE, "agent");
            xb_add(&bar[XB_XGEN(b.x)], 1u);
            asm volatile("s_waitcnt vmcnt(0)" ::: "memory");
        } else {
            XB_SPIN(xb_ld(&bar[XB_XGEN(b.x)]) == gen, bar);
            __builtin_amdgcn_fence(__ATOMIC_ACQUIRE, "agent");
            asm volatile("s_waitcnt vmcnt(0)" ::: "memory");
        }
    }
    __syncthreads();
}

constexpr size_t S_CTL = 65 * MiB + 65536;
constexpr int LDS_ST_OFF = 131072 + 64;
constexpr int NPHASE = 27;
__global__ void __launch_bounds__(NTHREADS, 2) mega_fwd(Args args) {
#define INP(i) (*(const float* const volatile __attribute__((address_space(4)))*)((const __attribute__((address_space(4))) char*)__builtin_amdgcn_kernarg_segment_ptr() + 8 * (i)))
    extern __shared__ __attribute__((aligned(16))) unsigned char lds_raw[];
    LAS unsigned char* lds = (LAS unsigned char*)lds_raw;
#define G ((int)gridDim.x)
#define bid ((int)blockIdx.x)
#define NGW (G * 8)
#define NGT (G * NTHREADS)
#define PHASE_IDS int tid = threadIdx.x; asm volatile("" : "+v"(tid)); const int lane = tid & 63; const int wave = __builtin_amdgcn_readfirstlane(tid >> 6); const int gw = bid * 8 + wave, gt = bid * NTHREADS + tid; (void)lane; (void)gw; (void)gt
    unsigned char* ws = args.ws;
    const int lo = args.ph_lo, hi_ph = args.ph_hi;
#ifndef DUPMASK
#define DUPMASK 0u
#endif
#define IN(k) (lo <= (k) && (k) < hi_ph)
#define REP(k) for (int rep_ = 0; rep_ < 1 + (int)((DUPMASK >> (k)) & 1u); ++rep_)
#if MK_MULTI
#define SEAM(k) do { } while (0)
#else
#define SEAM(k) do { if (IN(k) && IN((k) + 1)) { xcd_barrier(xbar); } } while (0)
#endif
#if !MK_MULTI
    if (threadIdx.x < 2) ((volatile LAS unsigned*)(lds + LDS_ST_OFF))[threadIdx.x] = 0u;
    __syncthreads();
    const XcdBarrier xbar = xcd_barrier_post((unsigned*)(ws + S_CTL), (volatile LAS unsigned*)(lds + LDS_ST_OFF));
    if (args.ph_lo < 0) cg::this_grid().sync();
#endif
    const float* x = INP(0); const float* mem = INP(1); const int* positions = (const int*)INP(2);
    bf16* XH = (bf16*)(ws + A_XH);
    bf16* QDb = (bf16*)args.out; bf16* KDb = (bf16*)args.out + (size_t)T * 1024;
    bf16* XN = (bf16*)(ws + A_XN);

    REP(0) if (IN(0)) {
        PHASE_IDS;
        LAS float* scr = (LAS float*)(lds + wave * 8704);
        for (int job = 0; job < 18; ++job) {
            const float* W; int K, N, mode = 0; bf16* dst;
            switch (job) {
                case 0: W = INP(4); K = 1024; N = 1184; dst = (bf16*)(ws + W_WIN); break;
                case 1: W = INP(10); K = 256; N = 768; dst = (bf16*)(ws + W_WUQ); break;
                case 2: W = INP(11); K = 128; N = 1024; dst = (bf16*)(ws + W_WUKV); break;
                case 3: W = INP(14); K = 1024; N = 1024; dst = (bf16*)(ws + W_WO0); break;
                case 4: W = INP(15); K = 1024; N = 3072; mode = 3; dst = (bf16*)(ws + W_WQKV); break;
                case 5: W = INP(20); K = 1024; N = 1024; dst = (bf16*)(ws + W_WDO); break;
                case 6: case 7: W = INP(23) + (size_t)(job - 6) * 1024 * 512; K = 1024; N = 512; dst = (bf16*)(ws + W_WMQ) + (size_t)(job - 6) * 512 * 1024; break;
                case 8: case 9: W = INP(24) + (size_t)(job - 8) * 1024 * 1024; K = 1024; N = 1024; dst = (bf16*)(ws + W_WMKV) + (size_t)(job - 8) * 1024 * 1024; break;
                case 10: case 11: W = INP(27) + (size_t)(job - 10) * 512 * 1024; K = 512; N = 1024; dst = (bf16*)(ws + W_WMO) + (size_t)(job - 10) * 1024 * 512; break;
                case 12: case 13: W = INP(29) + (size_t)(job - 12) * 1024 * DFF; K = 1024; N = DFF; mode = 1; dst = (bf16*)(ws + W_WGU) + (size_t)(job - 12) * 5632 * 1024; break;
                case 14: case 15: W = INP(30) + (size_t)(job - 14) * 1024 * DFF; K = 1024; N = DFF; mode = 2; dst = (bf16*)(ws + W_WGU) + (size_t)(job - 14) * 5632 * 1024; break;
                default: W = INP(31) + (size_t)(job - 16) * DFF * 1024; K = DFF; N = 1024; dst = (bf16*)(ws + W_WD) + (size_t)(job - 16) * 1024 * DFF; break;
            }
            const int nitems = (K / 64) * (N / 32);
            for (int it = gw; it < nitems; it += NGW) transpose_item(W, K, N, dst, mode, scr, it, lane);
        }
        { u32x4* z = (u32x4*)((bf16*)(ws + W_WIN) + (size_t)1184 * 1024); const u32x4 zero = {0u, 0u, 0u, 0u};
          for (int i = gt; i < 96 * 1024 / 8; i += NGT) z[i] = zero; }
        norm_phase(x, INP(3), XN, gw, NGW, lane);
        for (int it = gw; it < 2 * 512; it += NGW) { const int ly = it >> 9, r = it & 511;
            norm_row_1024(mem + (size_t)r * DM, INP(22) + ly * DM, (bf16*)(ws + S_MN) + ((size_t)ly * 512 + r) * DM, lane); }
        { float2* rope = (float2*)(ws + S_ROPE);
          for (int e = gt; e < T * 16; e += NGT) { const int row = e >> 4, i = e & 15;
              const float b4 = (i & 3) == 0 ? 1.0f : (i & 3) == 1 ? 0.5623413251903491f : (i & 3) == 2 ? 0.31622776601683794f : 0.1778279410038923f;
              const float p10 = (i >> 2) == 0 ? 1.0f : (i >> 2) == 1 ? 0.1f : (i >> 2) == 2 ? 0.01f : 0.001f;
              const float inv = (float)((double)b4 * (double)p10);
              const float ang = (float)positions[row] * inv;
              double rev = (double)ang * 0.15915494309189535; rev -= rint(rev);
              const float fr = (float)rev;
              rope[e] = make_float2(__builtin_amdgcn_cosf(fr), __builtin_amdgcn_sinf(fr)); } }
        if (gt == 0) { const float* lf = INP(18); float a = 0.f, b = 0.f;
            for (int i = 0; i < 64; ++i) { a += lf[i] * lf[64 + i]; b += lf[128 + i] * lf[192 + i]; }
            const float lambda_init = 0.8f - 0.6f * expf(-0.3f);
            *(float*)(ws + S_LAM) = expf(a) - expf(b) + lambda_init; }
    }
    SEAM(0);
    REP(1) if (IN(1)) {
        run_gemm(lds, XN, (const bf16*)(ws + W_WIN), T, ZW, 1024, pg8::EpiStore{(bf16*)(ws + A_Z), ZW}, bid);
        run_gemm(lds, (const bf16*)(ws + S_MN), (const bf16*)(ws + W_WMKV), 512, 1024, 1024, pg8::EpiStore{(bf16*)(ws + S_MKV), 1024}, (bid + 128) % G);
        run_gemm(lds, (const bf16*)(ws + S_MN) + (size_t)512 * 1024, (const bf16*)(ws + W_WMKV) + (size_t)1024 * 1024, 512, 1024, 1024, pg8::EpiStore{(bf16*)(ws + S_MKV) + (size_t)512 * 1024, 1024}, (bid + 192) % G);
    }
    SEAM(1);
    REP(2) if (IN(2)) {
        PHASE_IDS;
        const bf16* Z = (const bf16*)(ws + A_Z);
        for (int it = gw; it < 2 * T; it += NGW) {
            const int row = it >> 1; const bf16* zr = Z + (size_t)row * ZW;
            if ((it & 1) == 0) {
                const u32x4 v = *(const u32x4*)(zr + lane * 8);
                float ss = chunk_ss(v); ss += shfl_xor_l(ss, 1, lane); ss += shfl_xor_l(ss, 2, lane); ss += shfl_xor_l(ss, 4, lane);
                const float r = (1.0f / sqrtf(ss * (1.f / 64.f) + EPS)) * (0.125f * LOG2E);
                *(u32x4*)((bf16*)(ws + A_QA) + (size_t)row * 512 + lane * 8) = chunk_scale(v, r, INP(5) + (lane & 7) * 8);
            } else {
                const int seg = lane < 16 ? 0 : (lane < 32 ? 1 : 2);
                const int col = seg == 0 ? 512 + lane * 8 : (seg == 1 ? 1024 + (lane - 16) * 8 : 768 + (lane - 32) * 8);
                const u32x4 v = *(const u32x4*)(zr + col);
                float ss = chunk_ss(v); ss += shfl_xor_l(ss, 1, lane); ss += shfl_xor_l(ss, 2, lane); ss += shfl_xor_l(ss, 4, lane);
                { const float t8 = shfl_xor_l(ss, 8, lane); if (seg >= 1) ss += t8; }
                { const float t16 = shfl_xor_l(ss, 16, lane); if (seg == 2) ss += t16; }
                const float n = seg == 0 ? 64.f : (seg == 1 ? 128.f : 256.f);
                const float r = 1.0f / sqrtf(ss / n + EPS);
                const float* g = seg == 0 ? INP(6) + (lane & 7) * 8 : (seg == 1 ? INP(9) + (lane - 16) * 8 : INP(8) + (lane - 32) * 8);
                bf16* d = seg == 0 ? (bf16*)(ws + A_KA) + (size_t)row * 128 + lane * 8 : (seg == 1 ? (bf16*)(ws + A_CKVN) + (size_t)row * 128 + (lane - 16) * 8 : (bf16*)(ws + A_CQN) + (size_t)row * 256 + (lane - 32) * 8);
                *(u32x4*)d = chunk_scale(v, r, g);
            }
        }
        for (int j = gt; j < 2 * 512 * 4; j += NGT) { const int ly = j >> 11, row = (j >> 2) & 511, h = j & 3;
            rms_group<128>((const bf16*)(ws + S_MKV) + ((size_t)ly * 512 + row) * 1024 + h * 128, (bf16*)(ws + S_MK) + ((size_t)ly * 512 + row) * 512 + h * 128, INP(26) + ly * 128, 1.0f); }
        transpose_tiles<2>(lds, Z, ZW, 640, 64, 2, (bf16*)(ws + A_VTA), 128, SEQ, T, bid, G, tid);
        for (int ly = 0; ly < 2; ++ly)
            transpose_tiles<4>(lds, (const bf16*)(ws + S_MKV) + (size_t)ly * 512 * 1024, 1024, 512, 64, 8, (bf16*)(ws + S_VTM) + (size_t)ly * 2 * 512 * 256, 512, MEMT, 512, bid, G, tid);
    }
    SEAM(2);
    REP(3) if (IN(3)) {
#ifndef NO_P3
        run_gemm(lds, (const bf16*)(ws + A_CQN), (const bf16*)(ws + W_WUQ), T, 768, 256, pg8::EpiStore{(bf16*)(ws + A_QF), 768}, bid);
        run_gemm(lds, (const bf16*)(ws + A_CKVN), (const bf16*)(ws + W_WUKV), T, 1024, 128, pg8::EpiStore{(bf16*)(ws + A_KV), 1024}, bid);
#endif
    }
    SEAM(3);
    REP(4) if (IN(4)) {
        PHASE_IDS;
        const bf16* Z = (const bf16*)(ws + A_Z); const bf16* QF = (const bf16*)(ws + A_QF); const bf16* KV = (const bf16*)(ws + A_KV);
        const float2* rope = (const float2*)(ws + S_ROPE);
        const float qsc = 0.10206207261596577f * LOG2E;
        for (int it = gw; it < 2 * T * 2; it += NGW) {
            const int which = it >= T * 2, j = which ? it - T * 2 : it, row = j >> 1, h = (j & 1) * 4 + (lane >> 4), sub = lane & 15;
            const bool act = sub < 12;
            const bf16* src = !which ? QF + (size_t)row * 768 + h * 96 + sub * 8 : (sub < 8 ? KV + (size_t)row * 1024 + h * 128 + sub * 8 : Z + (size_t)row * ZW + 1152 + (sub - 8) * 8);
            const u32x4 zero4 = {0u, 0u, 0u, 0u};
            const u32x4 v = act ? *(const u32x4*)src : zero4;
            float ss = chunk_ss(v); ss += shfl_xor_l(ss, 1, lane); ss += shfl_xor_l(ss, 2, lane); ss += shfl_xor_l(ss, 4, lane); ss += shfl_xor_l(ss, 8, lane);
            const float r = (1.0f / sqrtf(ss * (1.f / 96.f) + EPS)) * (which ? 1.0f : qsc);
            const float* gain = which ? INP(13) : INP(12);
            u32x4 pv;
            pv.x = __builtin_amdgcn_ds_bpermute((lane ^ 2) << 2, v.x); pv.y = __builtin_amdgcn_ds_bpermute((lane ^ 2) << 2, v.y);
            pv.z = __builtin_amdgcn_ds_bpermute((lane ^ 2) << 2, v.z); pv.w = __builtin_amdgcn_ds_bpermute((lane ^ 2) << 2, v.w);
            if (act) {
                bf16* dst = (bf16*)(ws + (which ? A_KB : A_QB)) + (size_t)row * 768 + h * 96 + sub * 8;
                float f[8]; UNPK8(v, f);
                const float* g = gain + sub * 8;
#pragma unroll
                for (int i = 0; i < 8; ++i) f[i] *= r * g[i];
                if (sub >= 8) {
                    float pf_[8]; UNPK8(pv, pf_);
                    const float* gp = gain + (sub ^ 2) * 8; const float2* cs = rope + (size_t)row * 16 + (sub & 1) * 8;
#pragma unroll
                    for (int i = 0; i < 8; ++i) { const float pn = pf_[i] * r * gp[i]; const float2 c = cs[i];
                        f[i] = (sub < 10) ? (f[i] * c.x - pn * c.y) : (f[i] * c.x + pn * c.y); }
                }
                u32x4 o; PACK8(o, f); *(u32x4*)dst = o;
            }
        }
        transpose_tiles<4>(lds, KV, 1024, 64, 128, 8, (bf16*)(ws + A_VTB), 512, SEQ, T, bid, G, tid);
    }
    SEAM(4);
    REP(5) if (IN(5)) {
        bf16* ATT = (bf16*)(ws + A_ATT);
        float mgq = 0.f, mgk = 0.f;
        { const float* g1 = INP(12); const float* g2 = INP(13);
          for (int i = 0; i < 96; ++i) { mgq = fmaxf(mgq, fabsf(g1[i])); mgk = fmaxf(mgk, fabsf(g2[i])); } }
        const bool mla_skipmax = 2.0f * (9.797959f * mgq * mgk * LOG2E * 1.05f) < 60.0f;
        for (int j = bid; j < 1024; j += G) {
            int combo, qb; causal_slot(j, 16, combo, qb);
            const int b = combo >> 3, h = combo & 7; const size_t row0 = (size_t)b * SEQ + qb * 256;
#ifndef NO_MLA
            attn_unit<96, 64, AF_CAUSAL, 768, 768, SEQ, 1024>(lds, (const bf16*)(ws + A_QB) + row0 * 768 + h * 96, (const bf16*)(ws + A_KB) + (size_t)b * SEQ * 768 + h * 96,
                                         (const bf16*)(ws + A_VTB) + ((size_t)b * 512 + h * 64) * SEQ, ATT + row0 * 1024 + 512 + h * 64, qb * 256, 0, 4 * (qb + 1), 0.f, 0.f, nullptr, 0.f, mla_skipmax);
#endif
        }
        for (int j = bid; j < 1024; j += G) {
            const int b = j >> 9, h = (j >> 6) & 7, qb = j & 63, hk = h >> 2; const size_t row0 = (size_t)b * SEQ + qb * 256;
            const int q0 = qb * 256, klo = (q0 >= 128) ? (q0 - 128) / 64 : 0;
#ifndef NO_SWA
            attn_unit<64, 64, AF_CAUSAL | AF_WINDOW | AF_ALIBI | AF_SINK | AF_ROBUST, 512, 128, SEQ, 1024>(lds, (const bf16*)(ws + A_QA) + row0 * 512 + h * 64, (const bf16*)(ws + A_KA) + (size_t)b * SEQ * 128 + hk * 64,
                                         (const bf16*)(ws + A_VTA) + ((size_t)b * 128 + hk * 64) * SEQ, ATT + row0 * 1024 + h * 64, q0, klo, 4 * (qb + 1),
                                         exp2f(-(float)(h + 1)) * LOG2E, INP(7)[h] * LOG2E, nullptr, 0.f);
#endif
        }
    }
    SEAM(5);
    REP(6) if (IN(6)) run_gemm(lds, (const bf16*)(ws + A_ATT), (const bf16*)(ws + W_WO0), T, 1024, 1024, pg8::EpiResX<true, false>{x, XH, 1024}, bid);
    SEAM(6);
#pragma unroll 1
    for (int ly = 0; ly < 2; ++ly) {
        const int pb = ly ? 20 : 7;
        if (ly == 1) {
            if (IN(14)) { PHASE_IDS; norm_phase_h(XH, INP(3) + DM, XN, gw, NGW, lane); }
            SEAM(14);
            REP(15) if (IN(15)) run_gemm(lds, XN, (const bf16*)(ws + W_WQKV), T, 3072, 1024, pg8::EpiQKV{QDb, KDb, (bf16*)(ws + A_QKV), INP(16), INP(17), 0.125f * LOG2E}, bid);
            SEAM(15);
            REP(16) if (IN(16)) {
                PHASE_IDS;
                const bf16* QKV = (const bf16*)(ws + A_QKV);
                transpose_tiles<4>(lds, QKV, 3072, 2048, 64, 16, (bf16*)(ws + A_VTD), 1024, SEQ, T, bid, G, tid);
            }
            SEAM(16);
            REP(17) if (IN(17)) {
                float gq = 0.f, gk = 0.f;
                { const float* g1 = INP(16); const float* g2 = INP(17);
                  for (int i = 0; i < 64; ++i) { gq = fmaxf(gq, fabsf(g1[i])); gk = fmaxf(gk, fabsf(g2[i])); } }
                const float Bq = 8.0f * gq * gk * LOG2E * 1.05f;
                unsigned* qctr = (unsigned*)(ws + S_CTL) + 3600;
                volatile LAS unsigned* qslot = (volatile LAS unsigned*)(lds + LDS_ST_OFF + 8);
                for (;;) {
                    if (threadIdx.x == 0) *qslot = __hip_atomic_fetch_add(qctr, 1u, __ATOMIC_RELAXED, __HIP_MEMORY_SCOPE_AGENT);
                    __syncthreads();
                    const int j = (int)*qslot;
                    __syncthreads();
                    if (j >= 2048) break;
                    const int qb = 63 - (j >> 5), c = j & 31, h = 7 - (c >> 2), b = (c >> 1) & 1, st = c & 1; const size_t row0 = (size_t)b * SEQ + qb * 256;
                    const float slope2 = exp2f(-(float)(h + 1)) * LOG2E;
                    const int q0 = qb * 256, cutkeys = (int)((2.0f * Bq + 160.0f) / slope2) + 1;
                    const int klo = (q0 - 63 - cutkeys >= 0) ? (q0 - 63 - cutkeys) / 64 + 1 : 0;
#ifndef NO_DIFF
                    attn_unit<64, 128, AF_CAUSAL | AF_ALIBI | AF_REV, 1024, 1024, SEQ, 1024>(lds, QDb + row0 * 1024 + (2 * h + st) * 64, KDb + (size_t)b * SEQ * 1024 + (2 * h + st) * 64,
                                         (const bf16*)(ws + A_VTD) + ((size_t)b * 1024 + h * 128) * SEQ, (bf16*)(ws + (st ? A_O2 : A_O1)) + row0 * 1024 + h * 128, q0, klo, 4 * (qb + 1),
                                         slope2, 0.f, nullptr, 0.f, 2.0f * Bq < 60.0f);
#endif
                }
            }
            SEAM(17);
            REP(18) if (IN(18)) {
                PHASE_IDS;
                const float lam = *(const float*)(ws + S_LAM); const float osc = 1.0f - (0.8f - 0.6f * expf(-0.3f));
                const float* gsub = INP(19);
                for (int it = gw; it < T * 2; it += NGW) {
                    const size_t off = (size_t)it * 512 + lane * 8;
                    const u32x4 v1 = *(const u32x4*)((const bf16*)(ws + A_O1) + off), v2 = *(const u32x4*)((const bf16*)(ws + A_O2) + off);
                    float a[8], b2[8]; UNPK8(v1, a); UNPK8(v2, b2);
                    float ss = 0.f;
#pragma unroll
                    for (int i = 0; i < 8; ++i) { a[i] -= lam * b2[i]; ss += a[i] * a[i]; }
                    ss += shfl_xor_l(ss, 1, lane); ss += shfl_xor_l(ss, 2, lane); ss += shfl_xor_l(ss, 4, lane); ss += shfl_xor_l(ss, 8, lane);
                    const float r = (1.0f / sqrtf(ss * (1.f / 128.f) + EPS)) * osc;
                    const float* g = gsub + (lane & 15) * 8;
#pragma unroll
                    for (int i = 0; i < 8; ++i) a[i] *= r * g[i];
                    u32x4 w; PACK8(w, a); *(u32x4*)((bf16*)(ws + A_DO) + off) = w;
                }
            }
            SEAM(18);
            if (IN(19)) run_gemm(lds, (const bf16*)(ws + A_DO), (const bf16*)(ws + W_WDO), T, 1024, 1024, pg8::EpiResX<false, false>{XH, XH, 1024}, bid);
            SEAM(19);
        }
        REP(pb + 0) if (IN(pb + 0)) { PHASE_IDS; norm_phase_h(XH, INP(21) + ly * DM, XN, gw, NGW, lane); }
        SEAM(pb + 0);
        REP(pb + 1) if (IN(pb + 1)) run_gemm(lds, XN, (const bf16*)(ws + W_WMQ) + (size_t)ly * 512 * 1024, T, 512, 1024, pg8::EpiStore{(bf16*)(ws + A_QM), 512}, bid);
        SEAM(pb + 1);
        REP(pb + 2) if (IN(pb + 2)) {
            for (int j = bid; j < 512; j += G) {
                const int b = j >> 8, h = (j >> 6) & 3, qb = j & 63; const size_t row0 = (size_t)b * SEQ + qb * 256;
#ifndef NO_MEM
                attn_unit<128, 128, AF_QNORM, 512, 512, MEMT, 512>(lds, (const bf16*)(ws + A_QM) + row0 * 512 + h * 128, (const bf16*)(ws + S_MK) + ((size_t)ly * 512 + b * 256) * 512 + h * 128,
                                         (const bf16*)(ws + S_VTM) + (((size_t)ly * 2 + b) * 512 + h * 128) * 256, (bf16*)(ws + A_MO) + row0 * 512 + h * 128, 0, 0, 4,
                                         0.f, 0.f, INP(25) + ly * 128, 0.08838834764831845f * LOG2E);
#endif
            }
        }
        SEAM(pb + 2);
        if (IN(pb + 3)) run_gemm(lds, (const bf16*)(ws + A_MO), (const bf16*)(ws + W_WMO) + (size_t)ly * 1024 * 512, T, 1024, 512, pg8::EpiResX<false, false>{XH, XH, 1024}, bid);
        SEAM(pb + 3);
        if (IN(pb + 4)) { PHASE_IDS; norm_phase_h(XH, INP(28) + ly * DM, XN, gw, NGW, lane); }
        SEAM(pb + 4);
        REP(pb + 5) if (IN(pb + 5)) run_gemm(lds, XN, (const bf16*)(ws + W_WGU) + (size_t)ly * 5632 * 1024, T, 5632, 1024, pg8::EpiSwiglu{(bf16*)(ws + A_H), DFF}, bid);
        SEAM(pb + 5);
        if (IN(pb + 6)) { if (ly == 0) run_gemm(lds, (const bf16*)(ws + A_H), (const bf16*)(ws + W_WD), T, 1024, DFF, pg8::EpiResX<false, false>{XH, XH, 1024}, bid);
                          else run_gemm(lds, (const bf16*)(ws + A_H), (const bf16*)(ws + W_WD) + (size_t)1024 * DFF, T, 1024, DFF, pg8::EpiResX<false, true>{XH, args.out, 1024}, bid); }
        if (ly == 0) SEAM(13);
    }
#undef IN
#undef REP
#undef SEAM
#undef G
#undef bid
#undef NGW
#undef NGT
#undef PHASE_IDS
}

#undef INP
extern "C" void kernel_launch(void* const* d_in, const int* in_sizes, int n_in, void* d_out, int out_size, void* d_ws, size_t ws_size, hipStream_t stream) {
    static int grid = 0;
    if (grid == 0) {
        if (n_in != 32 || out_size != T * DM || ws_size < WS_NEED) { fprintf(stderr, "kernel_launch: unexpected shapes (n_in %d out %d ws %zu)\n", n_in, out_size, ws_size); grid = -1; return; }
        int dev = 0, cus = 0, per_cu = 0;
        hipGetDevice(&dev); hipDeviceGetAttribute(&cus, hipDeviceAttributeMultiprocessorCount, dev);
        if (hipFuncSetAttribute((const void*)mega_fwd, hipFuncAttributeMaxDynamicSharedMemorySize, LDS_BYTES) != hipSuccess) { fprintf(stderr, "kernel_launch: hipFuncSetAttribute failed\n"); grid = -1; return; }
        if (hipOccupancyMaxActiveBlocksPerMultiprocessor(&per_cu, (const void*)mega_fwd, NTHREADS, LDS_BYTES) != hipSuccess || per_cu < 1) { fprintf(stderr, "kernel_launch: occupancy query says %d\n", per_cu); per_cu = 1; }
        (void)hipGetLastError();
        grid = cus * 1;
        (void)per_cu;
    }
    if (grid < 0) return;
    Args a{};
    for (int i = 0; i < 32; ++i) a.in[i] = (const float*)d_in[i];
    a.out = (float*)d_out; a.ws = (unsigned char*)d_ws;
#if MK_MULTI
    for (int ph = 0; ph < NPHASE; ++ph) { a.ph_lo = ph; a.ph_hi = ph + 1; hipLaunchKernelGGL(mega_fwd, dim3(grid), dim3(NTHREADS), LDS_BYTES, stream, a); }
#else
    a.ph_lo = 0; a.ph_hi = NPHASE;
    if (hipMemsetAsync((char*)d_ws + S_CTL, 0, 16384, stream) != hipSuccess) { fprintf(stderr, "kernel_launch: memset failed\n"); return; }
    void* kargs[] = {&a};
    hipError_t e = hipLaunchCooperativeKernel((const void*)mega_fwd, dim3(grid), dim3(NTHREADS), kargs, LDS_BYTES, stream);
    if (e != hipSuccess) fprintf(stderr, "cooperative launch failed: %s (grid %d)\n", hipGetErrorString(e), grid);
#endif
}
```
